# Optimizing an MI355X kernel written in HIP

```python
import jax, jax.numpy as jnp
from jax import lax
import numpy as np

D_MODEL = 1024
BATCH = 8
SEQ = 2048
DEPTH = 1

MEM_LEN = 256
HEAD_DIM = 64
Q_BLOCK = 128
EPS = 1e-6
SB_HEADS = 8
SB_WIDTH = SB_HEADS * HEAD_DIM
DIL_CONFIG = ((128, 1), (512, 4), (2048, 16))
N_DIL_GROUPS = 3
DIL_HEADS_PER_GROUP = 4
DIL_HEADS = N_DIL_GROUPS * DIL_HEADS_PER_GROUP
DIL_WIDTH = DIL_HEADS * HEAD_DIM
DIL_OUT_WIDTH = DIL_HEADS_PER_GROUP * HEAD_DIM
DIL_STREAM_KEYS = 128
ALIBI_MAX_BIAS = 8.0
MEM_HEADS = 4
MEM_HEAD_DIM = 128
MEM_WIDTH = MEM_HEADS * MEM_HEAD_DIM
N_BRANCHES = 3
IN_WIDTH = 3 * SB_WIDTH + 3 * DIL_WIDTH + MEM_WIDTH
IN_SPLITS = (SB_WIDTH, 2 * SB_WIDTH, 3 * SB_WIDTH,
             3 * SB_WIDTH + DIL_WIDTH, 3 * SB_WIDTH + 2 * DIL_WIDTH, 3 * SB_WIDTH + 3 * DIL_WIDTH)
PEER_HEADS = 8
PEER_KEYS = 128
PEER_EXPERTS = PEER_KEYS * PEER_KEYS
PEER_TOPK = 16
PEER_QDIM = 256
PEER_HALF = PEER_QDIM // 2
PEER_CHUNK = 128

kernel_name = 'hybrid_sb_dilated_mem_peer_block'


def rms_norm(x, g):
    xf = x.astype(jnp.float32)
    y = xf * lax.rsqrt(jnp.mean(xf * xf, axis=-1, keepdims=True) + EPS)
    return (y * g.astype(jnp.float32)).astype(x.dtype)


def alibi_slopes(n):
    return jnp.exp2(-ALIBI_MAX_BIAS * jnp.arange(1, n + 1, dtype=jnp.float32) / n)


def stick_breaking_attention(q, k, v):
    B, H, S, dh = q.shape
    nb = S // Q_BLOCK
    q_blocks = q.reshape(B, H, nb, Q_BLOCK, dh).transpose(2, 0, 1, 3, 4)
    kpos = jnp.arange(S)
    scale = dh ** -0.5

    def block(args):
        q_blk, n = args
        z = jnp.einsum('bhqd,bhkd->bhqk', q_blk, k).astype(jnp.float32) * scale
        qpos = n * Q_BLOCK + jnp.arange(Q_BLOCK)
        past = kpos[None, :] < qpos[:, None]
        log_keep = jnp.where(past, jax.nn.log_sigmoid(-z), 0.0)
        between = lax.cumsum(log_keep, axis=3, reverse=True) - log_keep
        a = jnp.where(past, jnp.exp(jax.nn.log_sigmoid(z) + between), 0.0)
        return jnp.einsum('bhqk,bhkd->bhqd', a.astype(v.dtype), v)

    o = lax.map(block, (q_blocks, jnp.arange(nb)))
    return o.transpose(1, 2, 0, 3, 4).reshape(B, H, S, dh)


def dilated_group_attention(q, k, v, dilation, slopes):
    B, S, H, dh = q.shape
    L = S // dilation
    nb = -(-L // Q_BLOCK)
    Lp = nb * Q_BLOCK

    def to_streams(t):
        t = t.reshape(B, L, dilation, H, dh).transpose(0, 2, 3, 1, 4)
        t = jnp.pad(t, ((0, 0), (0, 0), (0, 0), (0, Lp - L), (0, 0)))
        return t.reshape(B, dilation, H, nb, Q_BLOCK, dh)

    qs, ks, vs = to_streams(q), to_streams(k), to_streams(v)

    def with_prev(t):
        prev = jnp.pad(t, ((0, 0), (0, 0), (0, 0), (1, 0), (0, 0), (0, 0)))[:, :, :, :nb]
        return jnp.concatenate([prev, t], axis=4)

    kc, vc = with_prev(ks), with_prev(vs)
    qi = jnp.arange(Q_BLOCK)
    kj = jnp.arange(2 * Q_BLOCK) - Q_BLOCK
    gap = qi[:, None] - kj[None, :]
    blk = jnp.arange(nb)
    valid = ((gap >= 0) & (gap <= DIL_STREAM_KEYS))[None] & \
            ((blk[:, None, None] * Q_BLOCK + kj[None, None, :]) >= 0)
    s = jnp.einsum('brhnqd,brhnkd->brhnqk', qs, kc).astype(jnp.float32) * dh ** -0.5
    s = s - slopes[:, None, None, None] * (gap * dilation).astype(jnp.float32)
    s = jnp.where(valid, s, -1e30)
    lse = jax.nn.logsumexp(s, axis=-1)
    p = jnp.exp(s - lse[..., None])
    o = jnp.einsum('brhnqk,brhnkd->brhnqd', p.astype(v.dtype), vc)
    o = o.reshape(B, dilation, H, Lp, dh)[:, :, :, :L].transpose(0, 3, 1, 2, 4).reshape(B, S, H, dh)
    lse = lse.reshape(B, dilation, H, Lp)[..., :L].transpose(0, 3, 1, 2).reshape(B, S, H)
    return o, lse


def dilated_mixture(q, k, v, g_q, g_k):
    q = rms_norm(q, g_q)
    k = rms_norm(k, g_k)
    slopes = alibi_slopes(DIL_HEADS)
    outs, lses = [], []
    for g, (window, dilation) in enumerate(DIL_CONFIG):
        hs = slice(g * DIL_HEADS_PER_GROUP, (g + 1) * DIL_HEADS_PER_GROUP)
        o, lse = dilated_group_attention(q[:, :, hs], k[:, :, hs], v[:, :, hs], dilation, slopes[hs])
        outs.append(o)
        lses.append(lse)
    w = jax.nn.softmax(jnp.stack(lses, axis=2), axis=2)
    o = jnp.stack(outs, axis=2)
    return jnp.sum(w[..., None].astype(o.dtype) * o, axis=2)


def memory_attention(q, mem_h, w_kv, g_q, g_k):
    B, M, _ = mem_h.shape
    kv = (mem_h @ w_kv).reshape(B, M, 2, MEM_HEADS, MEM_HEAD_DIM)
    k = rms_norm(kv[:, :, 0], g_k)
    v = kv[:, :, 1]
    q = rms_norm(q, g_q)
    s = jnp.einsum('bshd,bmhd->bhsm', q, k).astype(jnp.float32) * MEM_HEAD_DIM ** -0.5
    p = jax.nn.softmax(s, axis=-1)
    return jnp.einsum('bhsm,bmhd->bshd', p.astype(v.dtype), v)


def peer_ffn(h, w_q, subkeys, u, v):
    B, S, D = h.shape
    T = B * S
    hf = h.reshape(T, D)
    q = (hf @ w_q).reshape(T, PEER_HEADS, 2, PEER_HALF)
    sc = jnp.einsum('thpd,hpkd->thpk', q, subkeys).astype(jnp.float32)
    s1, i1 = lax.top_k(sc[:, :, 0], PEER_TOPK)
    s2, i2 = lax.top_k(sc[:, :, 1], PEER_TOPK)
    cand = (s1[..., :, None] + s2[..., None, :]).reshape(T, PEER_HEADS, PEER_TOPK * PEER_TOPK)
    cand_idx = (i1[..., :, None] * PEER_KEYS + i2[..., None, :]).reshape(T, PEER_HEADS, PEER_TOPK * PEER_TOPK)
    top_s, pos = lax.top_k(cand, PEER_TOPK)
    idx = jnp.take_along_axis(cand_idx, pos, axis=-1)
    gate = jax.nn.softmax(top_s, axis=-1)
    nc = T // PEER_CHUNK

    def chunk(args):
        hc, ic, gc = args
        act = jax.nn.gelu(jnp.einsum('chkd,cd->chk', u[ic], hc).astype(jnp.float32), approximate=False)
        w = (gc * act).astype(h.dtype)
        return jnp.einsum('chk,chkd->cd', w, v[ic])

    out = lax.map(chunk, (hf.reshape(nc, PEER_CHUNK, D),
                          idx.reshape(nc, PEER_CHUNK, PEER_HEADS, PEER_TOPK),
                          gate.reshape(nc, PEER_CHUNK, PEER_HEADS, PEER_TOPK)))
    return out.reshape(B, S, D)


def setup_inputs(seed: int = 0) -> dict:
    key = jax.random.key(seed)
    ks = jax.random.split(key, 24)
    D = D_MODEL

    def nrm(k, shape, scale):
        return jax.random.normal(k, shape, jnp.float32) * scale

    def gain(k, n):
        return 1.0 + 0.02 * jax.random.normal(k, (DEPTH, n), jnp.float32)

    return {
        'x': nrm(ks[0], (BATCH, SEQ, D), 1.0),
        'mem': nrm(ks[1], (BATCH, MEM_LEN, D), 1.0),
        'g_mix': gain(ks[2], D),
        'g_mem': gain(ks[3], D),
        'w_in': nrm(ks[4], (DEPTH, D, IN_WIDTH), D ** -0.5),
        'w_mem_kv': nrm(ks[5], (DEPTH, D, 2 * MEM_WIDTH), D ** -0.5),
        'g_q_dil': gain(ks[6], HEAD_DIM),
        'g_k_dil': gain(ks[7], HEAD_DIM),
        'g_q_mem': gain(ks[8], MEM_HEAD_DIM),
        'g_k_mem': gain(ks[9], MEM_HEAD_DIM),
        'w_o_sb': nrm(ks[10], (DEPTH, SB_WIDTH, D), SB_WIDTH ** -0.5),
        'w_o_dil': nrm(ks[11], (DEPTH, DIL_OUT_WIDTH, D), DIL_OUT_WIDTH ** -0.5),
        'w_o_mem': nrm(ks[12], (DEPTH, MEM_WIDTH, D), MEM_WIDTH ** -0.5),
        'w_gate': nrm(ks[13], (DEPTH, D, N_BRANCHES * D), D ** -0.5),
        'b_gate': nrm(ks[14], (DEPTH, N_BRANCHES * D), 0.02),
        'w_out': nrm(ks[15], (DEPTH, D, D), D ** -0.5),
        'g_ffn': gain(ks[16], D),
        'w_peer_q': nrm(ks[17], (DEPTH, D, PEER_HEADS * PEER_QDIM), D ** -0.5),
        'peer_subkeys': nrm(ks[18], (DEPTH, PEER_HEADS, 2, PEER_KEYS, PEER_HALF), PEER_HALF ** -0.5),
        'peer_u': nrm(ks[19], (DEPTH, PEER_EXPERTS, D), D ** -0.5),
        'peer_v': nrm(ks[20], (DEPTH, PEER_EXPERTS, D), (PEER_HEADS * PEER_TOPK) ** -0.5),
    }


def reference(x, mem, g_mix, g_mem, w_in, w_mem_kv, g_q_dil, g_k_dil, g_q_mem, g_k_mem,
              w_o_sb, w_o_dil, w_o_mem, w_gate, b_gate, w_out, g_ffn, w_peer_q,
              peer_subkeys, peer_u, peer_v):
    B, S, D = x.shape
    for l in range(DEPTH):
        h = rms_norm(x, g_mix[l])
        proj = h @ w_in[l]
        sb_q, sb_k, sb_v, d_q, d_k, d_v, m_q = jnp.split(proj, IN_SPLITS, axis=-1)

        def sb_heads(t):
            return t.reshape(B, S, SB_HEADS, HEAD_DIM).transpose(0, 2, 1, 3)

        y_sb = stick_breaking_attention(sb_heads(sb_q), sb_heads(sb_k), sb_heads(sb_v))
        y_sb = y_sb.transpose(0, 2, 1, 3).reshape(B, S, SB_WIDTH) @ w_o_sb[l]

        def dil_heads(t):
            return t.reshape(B, S, DIL_HEADS, HEAD_DIM)

        y_dil = dilated_mixture(dil_heads(d_q), dil_heads(d_k), dil_heads(d_v), g_q_dil[l], g_k_dil[l])
        y_dil = y_dil.reshape(B, S, DIL_OUT_WIDTH) @ w_o_dil[l]

        mem_h = rms_norm(mem, g_mem[l])
        y_mem = memory_attention(m_q.reshape(B, S, MEM_HEADS, MEM_HEAD_DIM), mem_h, w_mem_kv[l],
                                 g_q_mem[l], g_k_mem[l])
        y_mem = y_mem.reshape(B, S, MEM_WIDTH) @ w_o_mem[l]

        gates = jax.nn.sigmoid(h @ w_gate[l] + b_gate[l]).reshape(B, S, N_BRANCHES, D)
        merged = gates[:, :, 0] * y_sb + gates[:, :, 1] * y_dil + gates[:, :, 2] * y_mem
        x = x + merged @ w_out[l]

        h2 = rms_norm(x, g_ffn[l])
        x = x + peer_ffn(h2, w_peer_q[l], peer_subkeys[l], peer_u[l], peer_v[l])
    return x
```

```cpp
#include <hip/hip_runtime.h>
#include <hip/hip_cooperative_groups.h>
#include <stdint.h>
#include <cstdio>
namespace cg = cooperative_groups;

#ifndef MK_FUSED
#define MK_FUSED 0
#endif

typedef unsigned short u16;
typedef __attribute__((ext_vector_type(8))) short bf16x8;
typedef __attribute__((ext_vector_type(16))) float f32x16;
typedef __attribute__((ext_vector_type(2))) float f32x2;
typedef __attribute__((ext_vector_type(2))) __bf16 bf16x2_t;

#define DI __device__ __forceinline__
#define NTHR 256

constexpr int T_ = 16384;
constexpr size_t MB = 1048576;
constexpr size_t OFF_WINT = 0;
constexpr size_t OFF_WGT  = OFF_WINT + 4352ull * 1024 * 2;
constexpr size_t OFF_WKVT = OFF_WGT + 3072ull * 1024 * 2;
constexpr size_t OFF_WOT  = OFF_WKVT + 1024ull * 1024 * 2;
constexpr size_t OFF_WOUTT = OFF_WOT + 1024ull * 1280 * 2;
constexpr size_t OFF_WPQT = OFF_WOUTT + 1024ull * 1024 * 2;
constexpr size_t OFF_SUBK = OFF_WPQT + 2048ull * 1024 * 2;
constexpr size_t OFF_QKV  = 26 * MB;
constexpr size_t OFF_QSB  = OFF_QKV;
constexpr size_t OFF_KSB  = OFF_QSB + 16 * MB;
constexpr size_t OFF_VTSB = OFF_KSB + 16 * MB;
constexpr size_t OFF_QD   = OFF_VTSB + 16 * MB;
constexpr size_t OFF_KD   = OFF_QD + 24 * MB;
constexpr size_t OFF_VTD  = OFF_KD + 24 * MB;
constexpr size_t OFF_QM   = OFF_VTD + 24 * MB;
constexpr size_t OFF_KM   = OFF_QM + 16 * MB;
constexpr size_t OFF_VTM  = OFF_KM + 2 * MB;
constexpr size_t OFF_YSB  = OFF_QKV + 140 * MB;
constexpr size_t OFF_YD   = OFF_YSB + 16 * MB;
constexpr size_t OFF_YM   = OFF_YD + 24 * MB;
constexpr size_t OFF_LSE  = OFF_YM + 16 * MB;
constexpr size_t OFF_YDM  = OFF_LSE + 1 * MB;
constexpr size_t OFF_UBF  = OFF_QKV;
constexpr size_t OFF_VBF  = OFF_QKV + 32 * MB;
constexpr size_t OFF_MERGED = OFF_QKV + 64 * MB;
constexpr size_t OFF_TOPS = OFF_QKV + 96 * MB;
constexpr size_t OFF_TOPI = OFF_QKV + 112 * MB;
constexpr size_t OFF_GSCR = OFF_QKV + 96 * MB;
constexpr size_t OFF_H2   = OFF_YSB;
constexpr size_t OUT_OFF_H = 0;
constexpr size_t OUT_OFF_MEMH = 32 * MB;

struct Params {
  const float *x, *mem, *g_mix, *g_mem, *w_in, *w_mem_kv, *g_q_dil, *g_k_dil, *g_q_mem, *g_k_mem;
  const float *w_o_sb, *w_o_dil, *w_o_mem, *w_gate, *b_gate, *w_out, *g_ffn, *w_peer_q, *subkeys, *peer_u, *peer_v;
  float* out;
  char* ws;
};

DI uint32_t pack2(float a, float b) {
  f32x2 v = {a, b};
  bf16x2_t r = __builtin_convertvector(v, bf16x2_t);
  return __builtin_bit_cast(uint32_t, r);
}
DI uint4 pack8(const float* v) {
  uint4 r; r.x = pack2(v[0], v[1]); r.y = pack2(v[2], v[3]); r.z = pack2(v[4], v[5]); r.w = pack2(v[6], v[7]);
  return r;
}
DI float bf_lo(uint32_t u) { return __uint_as_float(u << 16); }
DI float bf_hi(uint32_t u) { return __uint_as_float(u & 0xffff0000u); }
DI float wave_sum(float v) {
#pragma unroll
  for (int o = 32; o; o >>= 1) v += __shfl_xor(v, o);
  return v;
}
DI f32x16 mfma32(bf16x8 a, bf16x8 b, f32x16 c) { return __builtin_amdgcn_mfma_f32_32x32x16_bf16(a, b, c, 0, 0, 0); }
DI bf16x8 ld16(const u16* p) { return *reinterpret_cast<const bf16x8*>(p); }
DI bf16x8 as_bf16x8(uint4 v) { return __builtin_bit_cast(bf16x8, v); }
DI f32x16 zero16() { f32x16 z; for (int i = 0; i < 16; ++i) z[i] = 0.f; return z; }
DI int launder(int v) { asm volatile("" : "+v"(v)); return v; }
DI int pi32(int i) { return (i & ~12) | ((i & 4) << 1) | ((i & 8) >> 1); }

struct LdPlain {
  const u16* p; int ld;
  DI const u16* operator()(int row, int k) const { return p + (uint32_t)(row * ld + k); }
};
DI int swz(int row, int ch) { return row * 128 + ((ch ^ ((row >> 1) & 7)) << 4); }
typedef __attribute__((address_space(3))) void lds_void;
DI void glds16(const u16* g, char* l) {
  __builtin_amdgcn_global_load_lds((const void*)g, (lds_void*)l, 16, 0, 0);
}
template <class LA, class LB>
DI void gemm_issue(const LA& la, const LB& lb, int k0, char* buf, uint32_t offA, uint32_t offB, int tid) {
#pragma unroll
  for (int i = 0; i < 4; ++i) {
    const u16* pa = la.p + (k0 + 32 * i * la.ld);
    const u16* pb = lb.p + (k0 + 32 * i * lb.ld);
    glds16(pa + offA, buf + (tid + 256 * i) * 16);
    glds16(pb + offB, buf + 16384 + (tid + 256 * i) * 16);
  }
}
template <class LA, class LB>
DI void gemm_mainloop(f32x16 (&acc)[2][2], const LA& la, const LB& lb, int K, char* smem, int tid) {
  const int lane = tid & 63, w = tid >> 6, wm = w >> 1, wn = w & 1;
  const int n = lane & 31, h = lane >> 5;
  const int nk = K >> 6;
  const int row0 = tid >> 3, ch0 = (tid & 7) ^ ((row0 >> 1) & 7);
  const uint32_t offA = (uint32_t)(row0 * la.ld + ch0 * 8), offB = (uint32_t)(row0 * lb.ld + ch0 * 8);
  gemm_issue(la, lb, 0, smem, offA, offB, tid);
  asm volatile("s_waitcnt vmcnt(0)" ::: "memory");
  __syncthreads();
#pragma unroll 1
  for (int kt = 0; kt < nk; ++kt) {
    if (kt + 1 < nk) gemm_issue(la, lb, (kt + 1) * 64, smem + ((kt + 1) & 1) * 32768, offA, offB, tid);
    const char* sa = smem + (kt & 1) * 32768;
    const char* sb = sa + 16384;
#pragma unroll
    for (int ks = 0; ks < 4; ++ks) {
      bf16x8 af[2], bfr[2];
#pragma unroll
      for (int mi = 0; mi < 2; ++mi) af[mi] = *reinterpret_cast<const bf16x8*>(sa + swz(wm * 64 + mi * 32 + n, ks * 2 + h));
#pragma unroll
      for (int ni = 0; ni < 2; ++ni) bfr[ni] = *reinterpret_cast<const bf16x8*>(sb + swz(wn * 64 + ni * 32 + n, ks * 2 + h));
#pragma unroll
      for (int mi = 0; mi < 2; ++mi)
#pragma unroll
        for (int ni = 0; ni < 2; ++ni) acc[mi][ni] = mfma32(af[mi], bfr[ni], acc[mi][ni]);
    }
    asm volatile("s_waitcnt vmcnt(0)" ::: "memory");
    __syncthreads();
  }
}

constexpr int CLD = 132;
DI void stage_acc(const f32x16 (&acc)[2][2], float* Cs, int tid) {
  const int lane = tid & 63, w = tid >> 6, wm = w >> 1, wn = w & 1;
  const int n = lane & 31, h = lane >> 5;
#pragma unroll
  for (int mi = 0; mi < 2; ++mi)
#pragma unroll
    for (int ni = 0; ni < 2; ++ni)
#pragma unroll
      for (int r = 0; r < 16; ++r) {
        int row = wm * 64 + mi * 32 + (r & 3) + 8 * (r >> 2) + 4 * h;
        int col = wn * 64 + ni * 32 + n;
        Cs[row * CLD + col] = acc[mi][ni][r];
      }
}

template <int HD, bool NORM>
DI void epi_rowmajor(const float* Cs, u16* base, int H, int head0, const float* gain, float scale, int r, int SL, int tok0, int tid) {
  const int cc = tid & 15, c8 = cc * 8, hl = c8 / HD, d0 = c8 % HD;
  float g[8];
#pragma unroll
  for (int j = 0; j < 8; ++j) g[j] = NORM ? gain[d0 + j] * scale : scale;
  const int Lr = SL / r;
#pragma unroll 2
  for (int pass = 0; pass < 8; ++pass) {
    int row = (tid >> 4) + 16 * pass;
    float v[8];
    float4 v0 = *reinterpret_cast<const float4*>(Cs + row * CLD + c8);
    float4 v1 = *reinterpret_cast<const float4*>(Cs + row * CLD + c8 + 4);
    v[0] = v0.x; v[1] = v0.y; v[2] = v0.z; v[3] = v0.w; v[4] = v1.x; v[5] = v1.y; v[6] = v1.z; v[7] = v1.w;
    if (NORM) {
      float ss = 0.f;
#pragma unroll
      for (int j = 0; j < 8; ++j) ss += v[j] * v[j];
      ss += __shfl_xor(ss, 1); ss += __shfl_xor(ss, 2); ss += __shfl_xor(ss, 4);
      if (HD == 128) ss += __shfl_xor(ss, 8);
      float rstd = rsqrtf(ss * (1.f / HD) + 1e-6f);
#pragma unroll
      for (int j = 0; j < 8; ++j) v[j] *= rstd * g[j];
    } else {
#pragma unroll
      for (int j = 0; j < 8; ++j) v[j] *= g[j];
    }
    int token = tok0 + row, b = token / SL, t = token % SL;
    int pp = (t % r) * Lr + t / r;
    u16* dst = base + ((size_t)(b * H + head0 + hl) * SL + pp) * HD + d0;
    *reinterpret_cast<uint4*>(dst) = pack8(v);
  }
}
template <int HD>
DI void epi_transposed(const float* Cs, u16* base, int H, int head0, int r, int SL, int tok0, int tid) {
  const int b = tok0 / SL, t0 = tok0 % SL, Lr = SL / r;
#pragma unroll 2
  for (int pass = 0; pass < 8; ++pass) {
    int u = tid + 256 * pass, col = u & 127, cj = u >> 7, c = cj % r, j = cj / r;
    float v[8];
#pragma unroll
    for (int e = 0; e < 8; ++e) v[e] = Cs[(c + r * (8 * j + e)) * CLD + col];
    int hl = col / HD, d = col % HD;
    int pp = c * Lr + t0 / r + 8 * j;
    u16* dst = base + ((size_t)(b * H + head0 + hl) * HD + d) * SL + pp;
    *reinterpret_cast<uint4*>(dst) = pack8(v);
  }
}

DI void transpose_tile(const float* src, int N, u16* dst, int dst_ld, int tk, int tn, float* tile) {
  const int tid = threadIdx.x;
#pragma unroll
  for (int i = 0; i < 4; ++i) {
    int r = (tid >> 4) + 16 * i, c4 = (tid & 15) * 4;
    float4 v = *reinterpret_cast<const float4*>(src + (size_t)(tk * 64 + r) * N + tn * 64 + c4);
    tile[r * 65 + c4] = v.x; tile[r * 65 + c4 + 1] = v.y; tile[r * 65 + c4 + 2] = v.z; tile[r * 65 + c4 + 3] = v.w;
  }
  __syncthreads();
#pragma unroll
  for (int i = 0; i < 2; ++i) {
    int nn = (tid >> 3) + 32 * i, kc = (tid & 7) * 8;
    float v[8];
#pragma unroll
    for (int j = 0; j < 8; ++j) v[j] = tile[(kc + j) * 65 + nn];
    *reinterpret_cast<uint4*>(dst + (size_t)(tn * 64 + nn) * dst_ld + tk * 64 + kc) = pack8(v);
  }
  __syncthreads();
}
DI void rmsnorm_row(const float* src, const float* gain, u16* dst) {
  const int lane = threadIdx.x & 63;
  float4 v[4];
  float ss = 0.f;
#pragma unroll
  for (int i = 0; i < 4; ++i) {
    v[i] = *reinterpret_cast<const float4*>(src + i * 256 + lane * 4);
    ss += v[i].x * v[i].x + v[i].y * v[i].y + v[i].z * v[i].z + v[i].w * v[i].w;
  }
  ss = wave_sum(ss);
  float rstd = rsqrtf(ss * (1.f / 1024.f) + 1e-6f);
#pragma unroll
  for (int i = 0; i < 4; ++i) {
    float4 g = *reinterpret_cast<const float4*>(gain + i * 256 + lane * 4);
    uint2 o; o.x = pack2(v[i].x * rstd * g.x, v[i].y * rstd * g.y); o.y = pack2(v[i].z * rstd * g.z, v[i].w * rstd * g.w);
    *reinterpret_cast<uint2*>(dst + i * 256 + lane * 4) = o;
  }
}
DI void convert_range(const float* src, u16* dst, size_t n8, size_t start, size_t stride) {
  for (size_t i = start; i < n8; i += stride) {
    float4 a = *reinterpret_cast<const float4*>(src + i * 8);
    float4 b = *reinterpret_cast<const float4*>(src + i * 8 + 4);
    uint4 o; o.x = pack2(a.x, a.y); o.y = pack2(a.z, a.w); o.z = pack2(b.x, b.y); o.w = pack2(b.z, b.w);
    *reinterpret_cast<uint4*>(dst + i * 8) = o;
  }
}

__device__ void phase0(const Params& p, int bid, int nb, char* smem) {
  float* tile = reinterpret_cast<float*>(smem);
  char* ws = p.ws;
  const int NTT = 1088 + 768 + 256 + 128 + 64 + 128 + 256 + 512;
  for (int it = bid; it < NTT; it += nb) {
    int i = it;
    const float* src; int N; u16* dst; int ld;
    if (i < 1088) { src = p.w_in; N = 4352; dst = (u16*)(ws + OFF_WINT); ld = 1024; }
    else if ((i -= 1088) < 768) { src = p.w_gate; N = 3072; dst = (u16*)(ws + OFF_WGT); ld = 1024; }
    else if ((i -= 768) < 256) { src = p.w_mem_kv; N = 1024; dst = (u16*)(ws + OFF_WKVT); ld = 1024; }
    else if ((i -= 256) < 128) { src = p.w_o_sb; N = 1024; dst = (u16*)(ws + OFF_WOT); ld = 1280; }
    else if ((i -= 128) < 64) { src = p.w_o_dil; N = 1024; dst = (u16*)(ws + OFF_WOT) + 512; ld = 1280; }
    else if ((i -= 64) < 128) { src = p.w_o_mem; N = 1024; dst = (u16*)(ws + OFF_WOT) + 768; ld = 1280; }
    else if ((i -= 128) < 256) { src = p.w_out; N = 1024; dst = (u16*)(ws + OFF_WOUTT); ld = 1024; }
    else { i -= 256; src = p.w_peer_q; N = 2048; dst = (u16*)(ws + OFF_WPQT); ld = 1024; }
    int ntn = N / 64;
    transpose_tile(src, N, dst, ld, i / ntn, i % ntn, tile);
  }
  const int w = __builtin_amdgcn_readfirstlane(threadIdx.x >> 6);
  u16* hbf = (u16*)((char*)p.out + OUT_OFF_H);
  u16* memh = (u16*)((char*)p.out + OUT_OFF_MEMH);
  for (int row = bid * 4 + w; row < T_ + 2048; row += nb * 4) {
    if (row < T_) rmsnorm_row(p.x + (size_t)row * 1024, p.g_mix, hbf + (size_t)row * 1024);
    else rmsnorm_row(p.mem + (size_t)(row - T_) * 1024, p.g_mem, memh + (size_t)(row - T_) * 1024);
  }
  convert_range(p.subkeys, (u16*)(ws + OFF_SUBK), 262144 / 8, (size_t)bid * NTHR + threadIdx.x, (size_t)nb * NTHR);
}

__device__ void phase1(const Params& p, int bid, int nb, char* smem) {
  char* ws = p.ws;
  float* Cs = reinterpret_cast<float*>(smem);
  const u16* hbf = (const u16*)((char*)p.out + OUT_OFF_H);
  const u16* memh = (const u16*)((char*)p.out + OUT_OFF_MEMH);
  const int NT1 = 128 * 34, NT2 = 16 * 8;
  for (int it = bid; it < NT1 + NT2; it += nb) {
    const int tid = launder(threadIdx.x);
    f32x16 acc[2][2];
#pragma unroll
    for (int a = 0; a < 2; ++a)
#pragma unroll
      for (int b = 0; b < 2; ++b) acc[a][b] = zero16();
    if (it < NT1) {
      int tm = it / 34, tn = it % 34;
      gemm_mainloop(acc, LdPlain{hbf + (size_t)tm * 128 * 1024, 1024}, LdPlain{(const u16*)(ws + OFF_WINT) + (size_t)tn * 128 * 1024, 1024}, 1024, smem, tid);
      stage_acc(acc, Cs, tid);
      __syncthreads();
      int c0 = tn * 128, tok0 = tm * 128;
      if (c0 < 512) epi_rowmajor<64, false>(Cs, (u16*)(ws + OFF_QSB), 8, c0 / 64, nullptr, 0.125f, 1, 2048, tok0, tid);
      else if (c0 < 1024) epi_rowmajor<64, false>(Cs, (u16*)(ws + OFF_KSB), 8, (c0 - 512) / 64, nullptr, 1.f, 1, 2048, tok0, tid);
      else if (c0 < 1536) epi_transposed<64>(Cs, (u16*)(ws + OFF_VTSB), 8, (c0 - 1024) / 64, 1, 2048, tok0, tid);
      else if (c0 < 2304) { int h0 = (c0 - 1536) / 64; epi_rowmajor<64, true>(Cs, (u16*)(ws + OFF_QD), 12, h0, p.g_q_dil, 0.125f, 1 << (2 * (h0 >> 2)), 2048, tok0, tid); }
      else if (c0 < 3072) { int h0 = (c0 - 2304) / 64; epi_rowmajor<64, true>(Cs, (u16*)(ws + OFF_KD), 12, h0, p.g_k_dil, 1.f, 1 << (2 * (h0 >> 2)), 2048, tok0, tid); }
      else if (c0 < 3840) { int h0 = (c0 - 3072) / 64; epi_transposed<64>(Cs, (u16*)(ws + OFF_VTD), 12, h0, 1 << (2 * (h0 >> 2)), 2048, tok0, tid); }
      else epi_rowmajor<128, true>(Cs, (u16*)(ws + OFF_QM), 4, (c0 - 3840) / 128, p.g_q_mem, 0.08838834764831845f, 1, 2048, tok0, tid);
    } else {
      int i2 = it - NT1, tm = i2 / 8, tn = i2 % 8;
      gemm_mainloop(acc, LdPlain{memh + (size_t)tm * 128 * 1024, 1024}, LdPlain{(const u16*)(ws + OFF_WKVT) + (size_t)tn * 128 * 1024, 1024}, 1024, smem, tid);
      stage_acc(acc, Cs, tid);
      __syncthreads();
      int c0 = tn * 128, tok0 = tm * 128;
      if (c0 < 512) epi_rowmajor<128, true>(Cs, (u16*)(ws + OFF_KM), 4, c0 / 128, p.g_k_mem, 1.f, 1, 256, tok0, tid);
      else epi_transposed<128>(Cs, (u16*)(ws + OFF_VTM), 4, (c0 - 512) / 128, 1, 256, tok0, tid);
    }
    __syncthreads();
  }
}

DI void pack_p(const float* a, bf16x8& p0, bf16x8& p1) {
  uint4 u0 = pack8(a), u1 = pack8(a + 8);
  p0 = as_bf16x8(u0); p1 = as_bf16x8(u1);
}
DI void write_ot(const f32x16& o, float scale, u16* rowp, int db, int h) {
#pragma unroll
  for (int g = 0; g < 4; ++g) {
    uint2 v; v.x = pack2(o[4 * g] * scale, o[4 * g + 1] * scale); v.y = pack2(o[4 * g + 2] * scale, o[4 * g + 3] * scale);
    *reinterpret_cast<uint2*>(rowp + 32 * db + 8 * g + 4 * h) = v;
  }
}

__device__ void sb_task(const char* ws, int b, int hd, int qt) {
  const int lane = threadIdx.x & 63, n = lane & 31, h = lane >> 5;
  const u16* Qb = (const u16*)(ws + OFF_QSB) + (size_t)(b * 8 + hd) * 2048 * 64;
  const u16* Kb = (const u16*)(ws + OFF_KSB) + (size_t)(b * 8 + hd) * 2048 * 64;
  const u16* Vb = (const u16*)(ws + OFF_VTSB) + (size_t)(b * 8 + hd) * 64 * 2048;
  const int q0 = qt * 32;
  bf16x8 qf[4];
#pragma unroll
  for (int ks = 0; ks < 4; ++ks) qf[ks] = ld16(Qb + (uint32_t)((q0 + n) * 64 + 32 * h + 8 * ks));
  f32x16 o0 = zero16(), o1 = zero16();
  float carry = 0.f;
  const int pin = pi32(n);
  for (int kb = qt; kb >= 0; --kb) {
    const int key0 = kb * 32;
    const u16* kp = Kb + (uint32_t)((key0 + pin) * 64 + 32 * h);
    bf16x8 kf[4];
#pragma unroll
    for (int ks = 0; ks < 4; ++ks) kf[ks] = ld16(kp + 8 * ks);
    bf16x8 vf[2][2];
#pragma unroll
    for (int db = 0; db < 2; ++db)
#pragma unroll
      for (int s = 0; s < 2; ++s) vf[db][s] = ld16(Vb + (uint32_t)((32 * db + n) * 2048 + key0 + 16 * s + 8 * h));
    f32x16 z = zero16();
#pragma unroll
    for (int ks = 0; ks < 4; ++ks) z = mfma32(kf[ks], qf[ks], z);
    const bool diag = (kb == qt);
    float sp[16], E[16];
#pragma unroll
    for (int r = 0; r < 16; ++r) {
      int kl = 16 * (r >> 3) + 8 * h + (r & 7);
      bool valid = (!diag) || (kl < n);
      float zz = z[r];
      float e = __expf(-fabsf(zz));
      float s = fmaxf(zz, 0.f) + __logf(1.f + e);
      sp[r] = valid ? s : 0.f;
    }
    E[7] = 0.f; E[15] = 0.f;
#pragma unroll
    for (int r = 6; r >= 0; --r) { E[r] = E[r + 1] + sp[r + 1]; E[r + 8] = E[r + 9] + sp[r + 9]; }
    float A0 = E[0] + sp[0], A1 = E[8] + sp[8];
    float B0 = __shfl_xor(A0, 32), B1 = __shfl_xor(A1, 32);
    float after0 = h ? (B1 + A1) : (B0 + A1 + B1);
    float after1 = h ? 0.f : B1;
    float a[16];
#pragma unroll
    for (int r = 0; r < 16; ++r) {
      int kl = 16 * (r >> 3) + 8 * h + (r & 7);
      bool valid = (!diag) || (kl < n);
      float bet = carry + ((r < 8) ? after0 : after1) + E[r];
      float v = __expf(z[r] - sp[r] - bet);
      a[r] = valid ? v : 0.f;
    }
    carry += A0 + A1 + B0 + B1;
    bf16x8 p0, p1;
    pack_p(a, p0, p1);
    o0 = mfma32(vf[0][0], p0, o0); o0 = mfma32(vf[0][1], p1, o0);
    o1 = mfma32(vf[1][0], p0, o1); o1 = mfma32(vf[1][1], p1, o1);
    if (__all(carry > 104.f)) break;
  }
  u16* rowp = (u16*)(ws + OFF_YSB) + (size_t)(b * 2048 + q0 + n) * 512 + hd * 64;
  write_ot(o0, 1.f, rowp, 0, h);
  write_ot(o1, 1.f, rowp, 1, h);
}

__device__ void dil_task(const char* ws, int b, int head, int pt) {
  const int lane = threadIdx.x & 63, n = lane & 31, h = lane >> 5;
  const int g = head >> 2, r_ = 1 << (2 * g), L = 2048 / r_;
  const int p0 = pt * 32, c = p0 / L, i0 = p0 % L;
  const float slope = exp2f(-8.f * (float)(head + 1) / 12.f) * (float)r_;
  const u16* Qb = (const u16*)(ws + OFF_QD) + (size_t)(b * 12 + head) * 2048 * 64;
  const u16* Kb = (const u16*)(ws + OFF_KD) + (size_t)(b * 12 + head) * 2048 * 64;
  const u16* Vb = (const u16*)(ws + OFF_VTD) + (size_t)(b * 12 + head) * 64 * 2048;
  bf16x8 qf[4];
#pragma unroll
  for (int ks = 0; ks < 4; ++ks) qf[ks] = ld16(Qb + (uint32_t)((p0 + n) * 64 + 32 * h + 8 * ks));
  f32x16 o0 = zero16(), o1 = zero16();
  float m = -1e30f, lsum = 0.f;
  const int pin = pi32(n);
  for (int rel = 0; rel >= -4; --rel) {
    const int ib = i0 + 32 * rel;
    if (ib < 0) break;
    const int key0 = c * L + ib;
    const u16* kp = Kb + (uint32_t)((key0 + pin) * 64 + 32 * h);
    bf16x8 kf[4];
#pragma unroll
    for (int ks = 0; ks < 4; ++ks) kf[ks] = ld16(kp + 8 * ks);
    bf16x8 vf[2][2];
#pragma unroll
    for (int db = 0; db < 2; ++db)
#pragma unroll
      for (int s = 0; s < 2; ++s) vf[db][s] = ld16(Vb + (uint32_t)((32 * db + n) * 2048 + key0 + 16 * s + 8 * h));
    f32x16 z = zero16();
#pragma unroll
    for (int ks = 0; ks < 4; ++ks) z = mfma32(kf[ks], qf[ks], z);
    float s[16];
    float bm = -1e30f;
#pragma unroll
    for (int r = 0; r < 16; ++r) {
      int kl = 16 * (r >> 3) + 8 * h + (r & 7);
      int gap = n - kl - 32 * rel;
      bool valid = (gap >= 0) && (gap <= 128);
      s[r] = valid ? (z[r] - slope * (float)gap) : -1e30f;
      bm = fmaxf(bm, s[r]);
    }
    bm = fmaxf(bm, __shfl_xor(bm, 32));
    float mn = fmaxf(m, bm);
    float alpha = __expf(m - mn);
    float a[16];
    float ps = 0.f;
#pragma unroll
    for (int r = 0; r < 16; ++r) { a[r] = __expf(s[r] - mn); ps += a[r]; }
    lsum = lsum * alpha + ps;
#pragma unroll
    for (int r = 0; r < 16; ++r) { o0[r] *= alpha; o1[r] *= alpha; }
    m = mn;
    bf16x8 p0, p1;
    pack_p(a, p0, p1);
    o0 = mfma32(vf[0][0], p0, o0); o0 = mfma32(vf[0][1], p1, o0);
    o1 = mfma32(vf[1][0], p0, o1); o1 = mfma32(vf[1][1], p1, o1);
  }
  float ltot = lsum + __shfl_xor(lsum, 32);
  float inv = 1.f / ltot;
  int t = c + r_ * (i0 + n);
  size_t token = (size_t)b * 2048 + t;
  u16* rowp = (u16*)(ws + OFF_YD) + (token * 12 + head) * 64;
  write_ot(o0, inv, rowp, 0, h);
  write_ot(o1, inv, rowp, 1, h);
  if (h == 0) ((float*)(ws + OFF_LSE))[token * 12 + head] = m + __logf(ltot);
}

__device__ void mem_task(const char* ws, int b, int hm, int qt) {
  const int lane = threadIdx.x & 63, n = lane & 31, h = lane >> 5;
  const u16* Qb = (const u16*)(ws + OFF_QM) + (size_t)(b * 4 + hm) * 2048 * 128;
  const u16* Kb = (const u16*)(ws + OFF_KM) + (size_t)(b * 4 + hm) * 256 * 128;
  const u16* Vb = (const u16*)(ws + OFF_VTM) + (size_t)(b * 4 + hm) * 128 * 256;
  const int q0 = qt * 32;
  bf16x8 qf[8];
#pragma unroll
  for (int ks = 0; ks < 8; ++ks) qf[ks] = ld16(Qb + (uint32_t)((q0 + n) * 128 + 64 * h + 8 * ks));
  f32x16 o[4];
#pragma unroll
  for (int db = 0; db < 4; ++db) o[db] = zero16();
  float m = -1e30f, lsum = 0.f;
  const int pin = pi32(n);
  for (int kb = 0; kb < 8; ++kb) {
    const int key0 = kb * 32;
    const u16* kp = Kb + (uint32_t)((key0 + pin) * 128 + 64 * h);
    f32x16 z = zero16();
#pragma unroll
    for (int ks = 0; ks < 8; ++ks) z = mfma32(ld16(kp + 8 * ks), qf[ks], z);
    float bm = -1e30f;
#pragma unroll
    for (int r = 0; r < 16; ++r) bm = fmaxf(bm, z[r]);
    bm = fmaxf(bm, __shfl_xor(bm, 32));
    float mn = fmaxf(m, bm);
    float alpha = __expf(m - mn);
    float a[16];
    float ps = 0.f;
#pragma unroll
    for (int r = 0; r < 16; ++r) { a[r] = __expf(z[r] - mn); ps += a[r]; }
    lsum = lsum * alpha + ps;
    m = mn;
    bf16x8 p0, p1;
    pack_p(a, p0, p1);
#pragma unroll
    for (int db = 0; db < 4; ++db) {
      bf16x8 vf0 = ld16(Vb + (uint32_t)((32 * db + n) * 256 + key0 + 8 * h));
      bf16x8 vf1 = ld16(Vb + (uint32_t)((32 * db + n) * 256 + key0 + 16 + 8 * h));
#pragma unroll
      for (int r = 0; r < 16; ++r) o[db][r] *= alpha;
      o[db] = mfma32(vf0, p0, o[db]);
      o[db] = mfma32(vf1, p1, o[db]);
    }
  }
  float ltot = lsum + __shfl_xor(lsum, 32);
  float inv = 1.f / ltot;
  u16* rowp = (u16*)(ws + OFF_YM) + (size_t)(b * 2048 + q0 + n) * 512 + hm * 128;
#pragma unroll
  for (int db = 0; db < 4; ++db) write_ot(o[db], inv, rowp, db, h);
}

__device__ void phase2(const Params& p, int bid, int nb) {
  const char* ws = p.ws;
  const int w = __builtin_amdgcn_readfirstlane(threadIdx.x >> 6);
  const int gw = bid * 4 + w, nw = nb * 4;
  for (int task = gw; task < 4096 + 2048 + 6144; task += nw) {
    if (task < 4096) {
      int qt = 63 - (task >> 6), bh = task & 63;
      sb_task(ws, bh >> 3, bh & 7, qt);
    } else if (task < 6144) {
      int i = task - 4096;
      mem_task(ws, (i >> 2) & 7, i & 3, i >> 5);
    } else {
      int i = task - 6144;
      int pt = i & 63, bh = i >> 6;
      dil_task(ws, bh / 12, bh % 12, pt);
    }
  }
}

__device__ void phase2b(const Params& p, int bid, int nb) {
  char* ws = p.ws;
  const size_t gt = (size_t)bid * NTHR + threadIdx.x, gs = (size_t)nb * NTHR;
  const u16* Yd = (const u16*)(ws + OFF_YD);
  const float* LSE = (const float*)(ws + OFF_LSE);
  u16* Ydm = (u16*)(ws + OFF_YDM);
  for (size_t i = gt; i < (size_t)T_ * 32; i += gs) {
    size_t t = i >> 5; int c = (int)(i & 31), hg = c >> 3, d0 = (c & 7) * 8;
    float l0 = LSE[t * 12 + hg], l1 = LSE[t * 12 + 4 + hg], l2 = LSE[t * 12 + 8 + hg];
    float mx = fmaxf(l0, fmaxf(l1, l2));
    float e0 = __expf(l0 - mx), e1 = __expf(l1 - mx), e2 = __expf(l2 - mx);
    float inv = 1.f / (e0 + e1 + e2);
    float wg[3] = {e0 * inv, e1 * inv, e2 * inv};
    float acc[8];
#pragma unroll
    for (int j = 0; j < 8; ++j) acc[j] = 0.f;
#pragma unroll
    for (int g = 0; g < 3; ++g) {
      uint4 v = *reinterpret_cast<const uint4*>(Yd + (t * 12 + g * 4 + hg) * 64 + d0);
      acc[0] += wg[g] * bf_lo(v.x); acc[1] += wg[g] * bf_hi(v.x); acc[2] += wg[g] * bf_lo(v.y); acc[3] += wg[g] * bf_hi(v.y);
      acc[4] += wg[g] * bf_lo(v.z); acc[5] += wg[g] * bf_hi(v.z); acc[6] += wg[g] * bf_lo(v.w); acc[7] += wg[g] * bf_hi(v.w);
    }
    *reinterpret_cast<uint4*>(Ydm + t * 256 + c * 8) = pack8(acc);
  }
  convert_range(p.peer_u, (u16*)(ws + OFF_UBF), (size_t)16384 * 1024 / 8, gt, gs);
  convert_range(p.peer_v, (u16*)(ws + OFF_VBF), (size_t)16384 * 1024 / 8, gt, gs);
}

__device__ void phase3(const Params& p, int bid, int nb, char* smem) {
  char* ws = p.ws;
  float* Cs = reinterpret_cast<float*>(smem);
  const u16* hbf = (const u16*)((char*)p.out + OUT_OFF_H);
  for (int it = bid; it < 128 * 8; it += nb) {
    const int tid = launder(threadIdx.x);
    const int lane = tid & 63, w = tid >> 6, wn = w & 1, n = lane & 31;
    int tm = it >> 3, tn = it & 7;
    f32x16 tot[2][2];
#pragma unroll
    for (int a = 0; a < 2; ++a)
#pragma unroll
      for (int b = 0; b < 2; ++b) tot[a][b] = zero16();
#pragma unroll 1
    for (int br = 0; br < 3; ++br) {
      f32x16 acc[2][2];
#pragma unroll
      for (int a = 0; a < 2; ++a)
#pragma unroll
        for (int b = 0; b < 2; ++b) acc[a][b] = zero16();
      gemm_mainloop(acc, LdPlain{hbf + (size_t)tm * 128 * 1024, 1024},
                    LdPlain{(const u16*)(ws + OFF_WGT) + (size_t)(br * 1024 + tn * 128) * 1024, 1024}, 1024, smem, tid);
      uint32_t* gscr = (uint32_t*)(ws + OFF_GSCR) + (size_t)bid * 8192 + tid;
#pragma unroll
      for (int ni = 0; ni < 2; ++ni) {
        float bias = p.b_gate[br * 1024 + tn * 128 + wn * 64 + ni * 32 + n];
#pragma unroll
        for (int mi = 0; mi < 2; ++mi)
#pragma unroll
          for (int r = 0; r < 8; ++r) {
            float g0 = __builtin_amdgcn_rcpf(1.f + __expf(-(acc[mi][ni][2 * r] + bias)));
            float g1 = __builtin_amdgcn_rcpf(1.f + __expf(-(acc[mi][ni][2 * r + 1] + bias)));
            gscr[((mi * 2 + ni) * 8 + r) * 256] = pack2(g0, g1);
            if ((r & 3) == 3) __builtin_amdgcn_sched_barrier(0);
          }
      }
#pragma unroll
      for (int a = 0; a < 2; ++a)
#pragma unroll
        for (int b = 0; b < 2; ++b) acc[a][b] = zero16();
      const u16* Y; int ldy, Kb, koff;
      if (br == 0) { Y = (const u16*)(ws + OFF_YSB); ldy = 512; Kb = 512; koff = 0; }
      else if (br == 1) { Y = (const u16*)(ws + OFF_YDM); ldy = 256; Kb = 256; koff = 512; }
      else { Y = (const u16*)(ws + OFF_YM); ldy = 512; Kb = 512; koff = 768; }
      gemm_mainloop(acc, LdPlain{Y + (size_t)tm * 128 * ldy, ldy},
                    LdPlain{(const u16*)(ws + OFF_WOT) + (size_t)(tn * 128) * 1280 + koff, 1280}, Kb, smem, tid);
#pragma unroll
      for (int mi = 0; mi < 2; ++mi)
#pragma unroll
        for (int ni = 0; ni < 2; ++ni)
#pragma unroll
          for (int r = 0; r < 8; ++r) {
            uint32_t gv = gscr[((mi * 2 + ni) * 8 + r) * 256];
            tot[mi][ni][2 * r] += bf_lo(gv) * acc[mi][ni][2 * r];
            tot[mi][ni][2 * r + 1] += bf_hi(gv) * acc[mi][ni][2 * r + 1];
            if ((r & 3) == 3) __builtin_amdgcn_sched_barrier(0);
          }
    }
    stage_acc(tot, Cs, tid);
    __syncthreads();
    {
      const int c8 = (tid & 15) * 8;
      u16* M = (u16*)(ws + OFF_MERGED);
#pragma unroll 2
      for (int pass = 0; pass < 8; ++pass) {
        int row = (tid >> 4) + 16 * pass;
        float v[8];
        float4 v0 = *reinterpret_cast<const float4*>(Cs + row * CLD + c8);
        float4 v1 = *reinterpret_cast<const float4*>(Cs + row * CLD + c8 + 4);
        v[0] = v0.x; v[1] = v0.y; v[2] = v0.z; v[3] = v0.w; v[4] = v1.x; v[5] = v1.y; v[6] = v1.z; v[7] = v1.w;
        *reinterpret_cast<uint4*>(M + (size_t)(tm * 128 + row) * 1024 + tn * 128 + c8) = pack8(v);
      }
    }
    __syncthreads();
  }
}

__device__ void phase4(const Params& p, int bid, int nb, char* smem) {
  char* ws = p.ws;
  float* Cs = reinterpret_cast<float*>(smem);
  for (int it = bid; it < 128 * 8; it += nb) {
    const int tid = launder(threadIdx.x);
    int tm = it >> 3, tn = it & 7;
    f32x16 acc[2][2];
#pragma unroll
    for (int a = 0; a < 2; ++a)
#pragma unroll
      for (int b = 0; b < 2; ++b) acc[a][b] = zero16();
    gemm_mainloop(acc, LdPlain{(const u16*)(ws + OFF_MERGED) + (size_t)tm * 128 * 1024, 1024},
                  LdPlain{(const u16*)(ws + OFF_WOUTT) + (size_t)(tn * 128) * 1024, 1024}, 1024, smem, tid);
    stage_acc(acc, Cs, tid);
    __syncthreads();
    const int c8 = (tid & 15) * 8;
#pragma unroll 2
    for (int pass = 0; pass < 8; ++pass) {
      int row = (tid >> 4) + 16 * pass;
      size_t off = (size_t)(tm * 128 + row) * 1024 + tn * 128 + c8;
      float4 v0 = *reinterpret_cast<const float4*>(Cs + row * CLD + c8);
      float4 v1 = *reinterpret_cast<const float4*>(Cs + row * CLD + c8 + 4);
      float4 x0 = *reinterpret_cast<const float4*>(p.x + off);
      float4 x1 = *reinterpret_cast<const float4*>(p.x + off + 4);
      v0.x += x0.x; v0.y += x0.y; v0.z += x0.z; v0.w += x0.w;
      v1.x += x1.x; v1.y += x1.y; v1.z += x1.z; v1.w += x1.w;
      *reinterpret_cast<float4*>(p.out + off) = v0;
      *reinterpret_cast<float4*>(p.out + off + 4) = v1;
    }
    __syncthreads();
  }
}

__device__ void phase5(const Params& p, int bid, int nb) {
  const int w = __builtin_amdgcn_readfirstlane(threadIdx.x >> 6);
  u16* h2 = (u16*)(p.ws + OFF_H2);
  for (int row = bid * 4 + w; row < T_; row += nb * 4)
    rmsnorm_row(p.out + (size_t)row * 1024, p.g_ffn, h2 + (size_t)row * 1024);
}

#define DPP_MAX(v, ctrl) { uint32_t _t = (uint32_t)__builtin_amdgcn_update_dpp((int)(v), (int)(v), ctrl, 0xf, 0xf, false); v = (_t > v) ? _t : v; }
#define DPP_ADDF(v, ctrl) { float _t = __builtin_bit_cast(float, __builtin_amdgcn_update_dpp(__builtin_bit_cast(int, v), __builtin_bit_cast(int, v), ctrl, 0xf, 0xf, false)); v += _t; }

__device__ void phase6(const Params& p, int bid, int nb, char* smem) {
  char* ws = p.ws;
  float* Cs = reinterpret_cast<float*>(smem);
  const u16* h2 = (const u16*)(ws + OFF_H2);
  float* TS = (float*)(ws + OFF_TOPS);
  int* TI = (int*)(ws + OFF_TOPI);
  for (int it = bid; it < 128 * 16; it += nb) {
    const int tid = launder(threadIdx.x), lane = tid & 63, w = tid >> 6, wm = w >> 1, wn = w & 1, n = lane & 31, h = lane >> 5;
    int tm = it >> 4, ct = it & 15;
    f32x16 acc[2][2];
#pragma unroll
    for (int a = 0; a < 2; ++a)
#pragma unroll
      for (int b = 0; b < 2; ++b) acc[a][b] = zero16();
    gemm_mainloop(acc, LdPlain{h2 + (size_t)tm * 128 * 1024, 1024},
                  LdPlain{(const u16*)(ws + OFF_WPQT) + (size_t)(ct * 128) * 1024, 1024}, 1024, smem, tid);
    {
      const u16* sk = (const u16*)(ws + OFF_SUBK) + (size_t)ct * 128 * 128;
      uint4 rb[8];
#pragma unroll
      for (int i = 0; i < 8; ++i) {
        int idx = tid + 256 * i, row = idx >> 4, c16 = idx & 15;
        rb[i] = *reinterpret_cast<const uint4*>(sk + row * 128 + c16 * 8);
      }
#pragma unroll
      for (int mi = 0; mi < 2; ++mi)
#pragma unroll
        for (int ni = 0; ni < 2; ++ni)
#pragma unroll
          for (int r = 0; r < 16; ++r) {
            int row = wm * 64 + mi * 32 + (r & 3) + 8 * (r >> 2) + 4 * h;
            int col = wn * 64 + ni * 32 + n;
            int panel = col >> 6, cc = col & 63;
            u16 bv = (u16)(pack2(acc[mi][ni][r], 0.f) & 0xffffu);
            *reinterpret_cast<u16*>(smem + panel * 16384 + swz(row, cc >> 3) + (cc & 7) * 2) = bv;
          }
#pragma unroll
      for (int i = 0; i < 8; ++i) {
        int idx = tid + 256 * i, row = idx >> 4, c16 = idx & 15;
        *reinterpret_cast<uint4*>(smem + 32768 + (c16 >> 3) * 16384 + swz(row, c16 & 7)) = rb[i];
      }
    }
    __syncthreads();
#pragma unroll
    for (int a = 0; a < 2; ++a)
#pragma unroll
      for (int b = 0; b < 2; ++b) acc[a][b] = zero16();
#pragma unroll
    for (int pn = 0; pn < 2; ++pn)
#pragma unroll
      for (int ks = 0; ks < 4; ++ks) {
        bf16x8 af[2], bfr[2];
#pragma unroll
        for (int mi = 0; mi < 2; ++mi) af[mi] = *reinterpret_cast<const bf16x8*>(smem + pn * 16384 + swz(wm * 64 + mi * 32 + n, ks * 2 + h));
#pragma unroll
        for (int ni = 0; ni < 2; ++ni) bfr[ni] = *reinterpret_cast<const bf16x8*>(smem + 32768 + pn * 16384 + swz(wn * 64 + ni * 32 + n, ks * 2 + h));
#pragma unroll
        for (int mi = 0; mi < 2; ++mi)
#pragma unroll
          for (int ni = 0; ni < 2; ++ni) acc[mi][ni] = mfma32(af[mi], bfr[ni], acc[mi][ni]);
      }
    __syncthreads();
    stage_acc(acc, Cs, tid);
    __syncthreads();
    {
      const int q = lane >> 4, li = lane & 15;
#pragma unroll 1
      for (int grp = 0; grp < 8; ++grp) {
        int row = w * 32 + grp * 4 + q;
        const float* rp = Cs + row * CLD;
        uint32_t k[8];
        float4 v0 = *reinterpret_cast<const float4*>(rp + li * 8);
        float4 v1 = *reinterpret_cast<const float4*>(rp + li * 8 + 4);
        float vv[8] = {v0.x, v0.y, v0.z, v0.w, v1.x, v1.y, v1.z, v1.w};
#pragma unroll
        for (int e = 0; e < 8; ++e) {
          uint32_t u = __float_as_uint(vv[e]);
          u = (u & 0x80000000u) ? ~u : (u | 0x80000000u);
          k[e] = (u & ~127u) | (uint32_t)(127 - (li * 8 + e));
        }
#pragma unroll
        for (int ph = 0; ph < 8; ++ph) {
#pragma unroll
          for (int e = (ph & 1); e + 1 < 8; e += 2) {
            uint32_t hi = k[e] > k[e + 1] ? k[e] : k[e + 1];
            uint32_t lo = k[e] > k[e + 1] ? k[e + 1] : k[e];
            k[e] = hi; k[e + 1] = lo;
          }
        }
        uint32_t res = 0;
#pragma unroll 4
        for (int itx = 0; itx < 16; ++itx) {
          uint32_t mx = k[0];
          DPP_MAX(mx, 0xB1);
          DPP_MAX(mx, 0x4E);
          DPP_MAX(mx, 0x141);
          DPP_MAX(mx, 0x140);
          bool win = (k[0] == mx);
#pragma unroll
          for (int e = 0; e < 7; ++e) k[e] = win ? k[e + 1] : k[e];
          k[7] = win ? 0u : k[7];
          res = (li == itx) ? mx : res;
        }
        int col = 127 - (int)(res & 127u);
        float val = rp[col];
        size_t o = ((size_t)(tm * 128 + row) * 16 + ct) * 16 + li;
        TS[o] = val; TI[o] = col;
      }
    }
    __syncthreads();
  }
}

__device__ void phase7(const Params& p, int bid, int nb, char* smem) {
  char* ws = p.ws;
  const int lane = threadIdx.x & 63, w = __builtin_amdgcn_readfirstlane(threadIdx.x >> 6), q = lane >> 4, li = lane & 15;
  int* lidx = reinterpret_cast<int*>(smem) + w * 256;
  float* lw = reinterpret_cast<float*>(smem) + w * 256 + 128;
  const u16* h2 = (const u16*)(ws + OFF_H2);
  const u16* U = (const u16*)(ws + OFF_UBF);
  const u16* V = (const u16*)(ws + OFF_VBF);
  const float* TS = (const float*)(ws + OFF_TOPS);
  const int* TI = (const int*)(ws + OFF_TOPI);
  int ca, cb;
  if (lane < 16) { ca = 0; cb = lane; } else if (lane < 24) { ca = 1; cb = lane - 16; } else if (lane < 29) { ca = 2; cb = lane - 24; }
  else if (lane < 33) { ca = 3; cb = lane - 29; } else if (lane < 36) { ca = 4; cb = lane - 33; } else if (lane < 38) { ca = 5; cb = lane - 36; }
  else if (lane < 40) { ca = 6; cb = lane - 38; } else if (lane < 42) { ca = 7; cb = lane - 40; } else if (lane < 50) { ca = lane - 34; cb = 0; }
  else { ca = 0; cb = 0; }
  const bool isc = lane < 50;
  for (int t = bid * 4 + w; t < T_; t += nb * 4) {
    uint4 hp[8];
#pragma unroll
    for (int i = 0; i < 8; ++i) hp[i] = *reinterpret_cast<const uint4*>(h2 + (size_t)t * 1024 + i * 128 + li * 8);
#pragma unroll 1
    for (int hh = 0; hh < 8; ++hh) {
      size_t o1 = ((size_t)t * 16 + hh * 2) * 16, o2 = o1 + 16;
      float key = isc ? (TS[o1 + ca] + TS[o2 + cb]) : -3.0e38f;
      int eidx = TI[o1 + ca] * 128 + TI[o2 + cb];
      int rank = 0;
#pragma unroll
      for (int j = 0; j < 50; ++j) {
        float kj = __builtin_bit_cast(float, __builtin_amdgcn_readlane(__builtin_bit_cast(int, key), j));
        rank += (kj > key || (kj == key && j < lane)) ? 1 : 0;
      }
      bool sel = isc && rank < 16;
      float mx = __builtin_bit_cast(float, __builtin_amdgcn_readlane(__builtin_bit_cast(int, key), 0));
      float e = sel ? __expf(key - mx) : 0.f;
      float sum = wave_sum(e);
      if (sel) { lidx[hh * 16 + rank] = eidx; lw[hh * 16 + rank] = e / sum; }
    }
    __builtin_amdgcn_fence(__ATOMIC_RELEASE, "wavefront");
    __builtin_amdgcn_wave_barrier();
#pragma unroll 2
    for (int j = 0; j < 32; ++j) {
      int e = lidx[4 * j + q];
      float gate = lw[4 * j + q];
      const u16* ur = U + (size_t)e * 1024 + li * 8;
      float d = 0.f;
#pragma unroll
      for (int i = 0; i < 8; ++i) {
        uint4 uv = *reinterpret_cast<const uint4*>(ur + i * 128);
        d = __builtin_amdgcn_fdot2_f32_bf16(__builtin_bit_cast(bf16x2_t, uv.x), __builtin_bit_cast(bf16x2_t, hp[i].x), d, false);
        d = __builtin_amdgcn_fdot2_f32_bf16(__builtin_bit_cast(bf16x2_t, uv.y), __builtin_bit_cast(bf16x2_t, hp[i].y), d, false);
        d = __builtin_amdgcn_fdot2_f32_bf16(__builtin_bit_cast(bf16x2_t, uv.z), __builtin_bit_cast(bf16x2_t, hp[i].z), d, false);
        d = __builtin_amdgcn_fdot2_f32_bf16(__builtin_bit_cast(bf16x2_t, uv.w), __builtin_bit_cast(bf16x2_t, hp[i].w), d, false);
      }
      DPP_ADDF(d, 0xB1); DPP_ADDF(d, 0x4E); DPP_ADDF(d, 0x141); DPP_ADDF(d, 0x140);
      float act = 0.5f * d * (1.f + erff(d * 0.70710678118654752f));
      __builtin_amdgcn_wave_barrier();
      if (li == 0) lw[4 * j + q] = gate * act;
    }
    __builtin_amdgcn_fence(__ATOMIC_RELEASE, "wavefront");
    __builtin_amdgcn_wave_barrier();
    float acc[16];
#pragma unroll
    for (int j = 0; j < 16; ++j) acc[j] = 0.f;
#pragma unroll 4
    for (int k = 0; k < 128; ++k) {
      int e = lidx[k];
      float wk = lw[k];
      const u16* vr = V + (size_t)e * 1024 + lane * 8;
      uint4 a = *reinterpret_cast<const uint4*>(vr);
      uint4 b = *reinterpret_cast<const uint4*>(vr + 512);
      acc[0] += wk * bf_lo(a.x); acc[1] += wk * bf_hi(a.x); acc[2] += wk * bf_lo(a.y); acc[3] += wk * bf_hi(a.y);
      acc[4] += wk * bf_lo(a.z); acc[5] += wk * bf_hi(a.z); acc[6] += wk * bf_lo(a.w); acc[7] += wk * bf_hi(a.w);
      acc[8] += wk * bf_lo(b.x); acc[9] += wk * bf_hi(b.x); acc[10] += wk * bf_lo(b.y); acc[11] += wk * bf_hi(b.y);
      acc[12] += wk * bf_lo(b.z); acc[13] += wk * bf_hi(b.z); acc[14] += wk * bf_lo(b.w); acc[15] += wk * bf_hi(b.w);
    }
    float* op = p.out + (size_t)t * 1024 + lane * 8;
#pragma unroll
    for (int hlf = 0; hlf < 2; ++hlf) {
      float4 x0 = *reinterpret_cast<const float4*>(op + hlf * 512);
      float4 x1 = *reinterpret_cast<const float4*>(op + hlf * 512 + 4);
      x0.x += acc[hlf * 8 + 0]; x0.y += acc[hlf * 8 + 1]; x0.z += acc[hlf * 8 + 2]; x0.w += acc[hlf * 8 + 3];
      x1.x += acc[hlf * 8 + 4]; x1.y += acc[hlf * 8 + 5]; x1.z += acc[hlf * 8 + 6]; x1.w += acc[hlf * 8 + 7];
      *reinterpret_cast<float4*>(op + hlf * 512) = x0;
      *reinterpret_cast<float4*>(op + hlf * 512 + 4) = x1;
    }
    __builtin_amdgcn_fence(__ATOMIC_RELEASE, "wavefront");
    __builtin_amdgcn_wave_barrier();
  }
}

constexpr int SMEM_BYTES = 128 * CLD * 4;

#if MK_FUSED
__global__ void __launch_bounds__(NTHR, 2) mega_kernel(Params p) {
  __shared__ __attribute__((aligned(16))) char smem[SMEM_BYTES];
  cg::grid_group grid = cg::this_grid();
  const int bid = blockIdx.x, nb = gridDim.x;
  phase0(p, bid, nb, smem); grid.sync();
  phase1(p, bid, nb, smem); grid.sync();
  phase2(p, bid, nb); grid.sync();
  phase2b(p, bid, nb); grid.sync();
  phase3(p, bid, nb, smem); grid.sync();
  phase4(p, bid, nb, smem); grid.sync();
  phase5(p, bid, nb); grid.sync();
  phase6(p, bid, nb, smem); grid.sync();
  phase7(p, bid, nb, smem);
}
#else
#define PHASE_KERNEL(name, call) \
  __global__ void __launch_bounds__(NTHR, 2) name(Params p) { \
    __shared__ __attribute__((aligned(16))) char smem[SMEM_BYTES]; \
    const int bid = blockIdx.x, nb = gridDim.x; (void)smem; call; }
PHASE_KERNEL(k_p0, phase0(p, bid, nb, smem))
PHASE_KERNEL(k_p1, phase1(p, bid, nb, smem))
PHASE_KERNEL(k_p2, phase2(p, bid, nb))
PHASE_KERNEL(k_p2b, phase2b(p, bid, nb))
PHASE_KERNEL(k_p3, phase3(p, bid, nb, smem))
PHASE_KERNEL(k_p4, phase4(p, bid, nb, smem))
PHASE_KERNEL(k_p5, phase5(p, bid, nb))
PHASE_KERNEL(k_p6, phase6(p, bid, nb, smem))
PHASE_KERNEL(k_p7, phase7(p, bid, nb, smem))
#endif

extern "C" void kernel_launch(void* const* d_in, const int* in_sizes, int n_in, void* d_out, int out_size, void* d_ws,
                              size_t ws_size, hipStream_t stream) {
  Params p{};
  p.x = (const float*)d_in[0]; p.mem = (const float*)d_in[1]; p.g_mix = (const float*)d_in[2]; p.g_mem = (const float*)d_in[3];
  p.w_in = (const float*)d_in[4]; p.w_mem_kv = (const float*)d_in[5]; p.g_q_dil = (const float*)d_in[6]; p.g_k_dil = (const float*)d_in[7];
  p.g_q_mem = (const float*)d_in[8]; p.g_k_mem = (const float*)d_in[9]; p.w_o_sb = (const float*)d_in[10]; p.w_o_dil = (const float*)d_in[11];
  p.w_o_mem = (const float*)d_in[12]; p.w_gate = (const float*)d_in[13]; p.b_gate = (const float*)d_in[14]; p.w_out = (const float*)d_in[15];
  p.g_ffn = (const float*)d_in[16]; p.w_peer_q = (const float*)d_in[17]; p.subkeys = (const float*)d_in[18]; p.peer_u = (const float*)d_in[19];
  p.peer_v = (const float*)d_in[20];
  p.out = (float*)d_out; p.ws = (char*)d_ws;
#if MK_FUSED
  static int grid_blocks = 0;
  if (!grid_blocks) {
    int dev = 0, cus = 0, per_cu = 0;
    hipGetDevice(&dev);
    hipDeviceGetAttribute(&cus, hipDeviceAttributeMultiprocessorCount, dev);
    hipOccupancyMaxActiveBlocksPerMultiprocessor(&per_cu, mega_kernel, NTHR, 0);
    if (per_cu > 2) per_cu = 2;
    if (per_cu < 1) per_cu = 1;
    grid_blocks = cus * per_cu;
  }
  void* args[] = {&p};
  hipError_t e = hipLaunchCooperativeKernel((void*)mega_kernel, dim3(grid_blocks), dim3(NTHR), args, 0, stream);
  if (e != hipSuccess) fprintf(stderr, "cooperative launch failed: %s (grid %d)\n", hipGetErrorString(e), grid_blocks);
#else
  const int G = 512;
  k_p0<<<G, NTHR, 0, stream>>>(p);
  k_p1<<<G, NTHR, 0, stream>>>(p);
  k_p2<<<G, NTHR, 0, stream>>>(p);
  k_p2b<<<G, NTHR, 0, stream>>>(p);
  k_p3<<<G, NTHR, 0, stream>>>(p);
  k_p4<<<G, NTHR, 0, stream>>>(p);
  k_p5<<<G, NTHR, 0, stream>>>(p);
  k_p6<<<G, NTHR, 0, stream>>>(p);
  k_p7<<<G, NTHR, 0, stream>>>(p);
#endif
}
```

```cpp
#include <hip/hip_runtime.h>
#include <hip/hip_cooperative_groups.h>
#include <stdint.h>
#include <cstdio>
namespace cg = cooperative_groups;

#ifndef PROBE_DUP
#define PROBE_DUP 0
#endif
#ifndef MK_FUSED
#define MK_FUSED 1
#endif

typedef unsigned short u16;
typedef __attribute__((ext_vector_type(8))) short bf16x8;
typedef __attribute__((ext_vector_type(16))) float f32x16;
typedef __attribute__((ext_vector_type(2))) float f32x2;
typedef __attribute__((ext_vector_type(2))) __bf16 bf16x2_t;

#define DI __device__ __forceinline__
#define NTHR 512
#define WPB 8

constexpr int T_ = 16384;
constexpr size_t MB = 1048576;
constexpr size_t OFF_WINT = 0;
constexpr size_t OFF_WGT  = OFF_WINT + 4352ull * 1024 * 2;
constexpr size_t OFF_WKVT = OFF_WGT + 3072ull * 1024 * 2;
constexpr size_t OFF_WOT  = OFF_WKVT + 1024ull * 1024 * 2;
constexpr size_t OFF_WOUTT = OFF_WOT + 1024ull * 1280 * 2;
constexpr size_t OFF_WPQT = OFF_WOUTT + 1024ull * 1024 * 2;
constexpr size_t OFF_SUBK = OFF_WPQT + 2048ull * 1024 * 2;
constexpr size_t OFF_QKV  = 26 * MB;
constexpr size_t OFF_QSB  = OFF_QKV;
constexpr size_t OFF_KSB  = OFF_QSB + 16 * MB;
constexpr size_t OFF_VTSB = OFF_KSB + 16 * MB;
constexpr size_t OFF_QD   = OFF_VTSB + 16 * MB;
constexpr size_t OFF_KD   = OFF_QD + 24 * MB;
constexpr size_t OFF_VTD  = OFF_KD + 24 * MB;
constexpr size_t OFF_QM   = OFF_VTD + 24 * MB;
constexpr size_t OFF_KM   = OFF_QM + 16 * MB;
constexpr size_t OFF_VTM  = OFF_KM + 2 * MB;
constexpr size_t OFF_YD   = OFF_QKV + 140 * MB;
constexpr size_t OFF_YM   = OFF_YD + 24 * MB;
constexpr size_t OFF_U8   = OFF_YM + 16 * MB;
constexpr size_t OFF_V8   = OFF_U8 + 16 * MB;
constexpr size_t OFF_USC  = OFF_V8 + 16 * MB;
constexpr size_t OFF_ROWSS = OFF_USC + 1 * MB;
constexpr size_t OFF_BAR  = OFF_ROWSS + 1 * MB;
constexpr size_t OFF_MERGED = OFF_QKV + 64 * MB;
constexpr size_t OFF_TOPS = OFF_QKV + 96 * MB;
constexpr size_t OFF_TOPI = OFF_QKV + 112 * MB;
constexpr size_t OFF_GSCR = OFF_QKV;
constexpr size_t OFF_TPARK = OFF_QKV + 16 * MB;
constexpr size_t OFF_XG   = OFF_YD;
constexpr size_t OUT_OFF_H = 0;
constexpr size_t OUT_OFF_MEMH = 32 * MB;
constexpr size_t OUT_OFF_YSB = 36 * MB;
constexpr size_t OUT_OFF_LSE = 52 * MB;
constexpr size_t OUT_OFF_YDM = 53 * MB;

struct Params {
  const float *x, *mem, *g_mix, *g_mem, *w_in, *w_mem_kv, *g_q_dil, *g_k_dil, *g_q_mem, *g_k_mem;
  const float *w_o_sb, *w_o_dil, *w_o_mem, *w_gate, *b_gate, *w_out, *g_ffn, *w_peer_q, *subkeys, *peer_u, *peer_v;
  float* out;
  char* ws;
};

DI uint32_t pack2(float a, float b) {
  f32x2 v = {a, b};
  bf16x2_t r = __builtin_convertvector(v, bf16x2_t);
  return __builtin_bit_cast(uint32_t, r);
}
DI uint4 pack8(const float* v) {
  uint4 r; r.x = pack2(v[0], v[1]); r.y = pack2(v[2], v[3]); r.z = pack2(v[4], v[5]); r.w = pack2(v[6], v[7]);
  return r;
}
DI float bf_lo(uint32_t u) { return __uint_as_float(u << 16); }
DI float bf_hi(uint32_t u) { return __uint_as_float(u & 0xffff0000u); }
DI float wave_sum(float v) {
#pragma unroll
  for (int o = 32; o; o >>= 1) v += __shfl_xor(v, o);
  return v;
}
DI f32x16 mfma32(bf16x8 a, bf16x8 b, f32x16 c) { return __builtin_amdgcn_mfma_f32_32x32x16_bf16(a, b, c, 0, 0, 0); }
DI bf16x8 ld16(const u16* p) { return *reinterpret_cast<const bf16x8*>(p); }
DI bf16x8 as_bf16x8(uint4 v) { return __builtin_bit_cast(bf16x8, v); }
DI f32x16 zero16() { f32x16 z; for (int i = 0; i < 16; ++i) z[i] = 0.f; return z; }
DI int launder(int v) { asm volatile("" : "+v"(v)); return v; }
DI char* uniform_ptr(char* p) {
  uint64_t v = (uint64_t)p;
  uint32_t lo = __builtin_amdgcn_readfirstlane((uint32_t)v), hi = __builtin_amdgcn_readfirstlane((uint32_t)(v >> 32));
  return (char*)(((uint64_t)hi << 32) | lo);
}
DI int launder_s(int v) { asm volatile("" : "+s"(v)); return v; }
DI int pi32(int i) { return (i & ~12) | ((i & 4) << 1) | ((i & 8) >> 1); }

struct LdPlain {
  const u16* p; int ld;
  DI const u16* operator()(int row, int k) const { return p + (uint32_t)(row * ld + k); }
};
DI int swz(int row, int ch) { return row * 128 + ((ch ^ ((row >> 1) & 7)) << 4); }
typedef __attribute__((address_space(3))) void lds_void;
DI void glds16(const u16* g, char* l) {
  __builtin_amdgcn_global_load_lds((const void*)g, (lds_void*)l, 16, 0, 0);
}
constexpr int STAGE_BYTES = 49152;
template <class LA, class LB>
DI void gemm_issue(const LA& la, const LB& lb, int k0, char* buf, uint32_t offA, uint32_t offB, int tid) {
#pragma unroll
  for (int i = 0; i < 4; ++i) {
    const u16* pa = la.p + (k0 + 64 * i * la.ld);
    glds16(pa + offA, buf + (tid + 512 * i) * 16);
  }
#pragma unroll
  for (int i = 0; i < 2; ++i) {
    const u16* pb = lb.p + (k0 + 64 * i * lb.ld);
    glds16(pb + offB, buf + 32768 + (tid + 512 * i) * 16);
  }
}
template <int OFF>
DI void lds_rd128(bf16x8& dst, uint32_t addr) {
  asm volatile("ds_read_b128 %0, %1 offset:%2" : "=v"(dst) : "v"(addr), "n"(OFF) : "memory");
}
#define LGKM_WAIT(N, a, b, c, d) asm volatile("s_waitcnt lgkmcnt(" #N ")" : "+v"(a), "+v"(b), "+v"(c), "+v"(d) :: "memory")
template <class LA, class LB>
DI void gemm_mainloop(f32x16 (&acc)[2][2], const LA& la, const LB& lb, int K, char* smem, int tid) {
  const int lane = tid & 63, w = tid >> 6, wm = w >> 1, wn = w & 1;
  const int n = lane & 31, h = lane >> 5;
  const int nk = K >> 6;
  const int row0 = tid >> 3, ch0 = (tid & 7) ^ ((row0 >> 1) & 7);
  const uint32_t offA = (uint32_t)(row0 * la.ld + ch0 * 8), offB = (uint32_t)(row0 * lb.ld + ch0 * 8);
  const uint32_t sbase = (uint32_t)(size_t)smem;
  const uint32_t fa0 = (uint32_t)swz(wm * 64 + n, h), fb0 = (uint32_t)swz(wn * 64 + n, h);
  gemm_issue(la, lb, 0, smem, offA, offB, tid);
  if (nk > 1) { gemm_issue(la, lb, 64, smem + STAGE_BYTES, offA, offB, tid); asm volatile("s_waitcnt vmcnt(6)" ::: "memory"); }
  else asm volatile("s_waitcnt vmcnt(0)" ::: "memory");
  __builtin_amdgcn_s_barrier();
  asm volatile("" ::: "memory");
  if (nk > 2) gemm_issue(la, lb, 128, smem + 2 * STAGE_BYTES, offA, offB, tid);
  bf16x8 af[2][2], bfr[2][2];
  lds_rd128<0>(af[0][0], sbase + fa0); lds_rd128<4096>(af[0][1], sbase + fa0);
  lds_rd128<32768>(bfr[0][0], sbase + fb0); lds_rd128<36864>(bfr[0][1], sbase + fb0);
  int st = 0;
#pragma unroll 1
  for (int kt = 0; kt < nk; ++kt) {
    const uint32_t sb_ = sbase + (uint32_t)(st * STAGE_BYTES);
    const int st1 = (st == 2) ? 0 : st + 1;
#pragma unroll
    for (int ks = 0; ks < 3; ++ks) {
      const int cur = ks & 1, nxt = cur ^ 1;
      const uint32_t aa = sb_ + (fa0 ^ (uint32_t)((ks + 1) << 5)), ab = sb_ + (fb0 ^ (uint32_t)((ks + 1) << 5));
      lds_rd128<0>(af[nxt][0], aa); lds_rd128<4096>(af[nxt][1], aa);
      lds_rd128<32768>(bfr[nxt][0], ab); lds_rd128<36864>(bfr[nxt][1], ab);
      LGKM_WAIT(4, af[cur][0], af[cur][1], bfr[cur][0], bfr[cur][1]);
#pragma unroll
      for (int mi = 0; mi < 2; ++mi)
#pragma unroll
        for (int ni = 0; ni < 2; ++ni) acc[mi][ni] = mfma32(af[cur][mi], bfr[cur][ni], acc[mi][ni]);
    }
    LGKM_WAIT(0, af[1][0], af[1][1], bfr[1][0], bfr[1][1]);
    if (kt + 1 < nk) {
      if (kt + 2 < nk) asm volatile("s_waitcnt vmcnt(6)" ::: "memory");
      else asm volatile("s_waitcnt vmcnt(0)" ::: "memory");
      __builtin_amdgcn_s_barrier();
      asm volatile("" ::: "memory");
      if (kt + 3 < nk) gemm_issue(la, lb, (kt + 3) * 64, smem + st * STAGE_BYTES, offA, offB, tid);
      const uint32_t sn = sbase + (uint32_t)(st1 * STAGE_BYTES);
      lds_rd128<0>(af[0][0], sn + fa0); lds_rd128<4096>(af[0][1], sn + fa0);
      lds_rd128<32768>(bfr[0][0], sn + fb0); lds_rd128<36864>(bfr[0][1], sn + fb0);
    }
#pragma unroll
    for (int mi = 0; mi < 2; ++mi)
#pragma unroll
      for (int ni = 0; ni < 2; ++ni) acc[mi][ni] = mfma32(af[1][mi], bfr[1][ni], acc[mi][ni]);
    st = st1;
  }
  __syncthreads();
}

constexpr int STAGE8_BYTES = 65536;
template <class LA, class LB>
DI void gemm_issue8(const LA& la, const LB& lb, int k0, char* buf, uint32_t offA, uint32_t offB, int tid) {
#pragma unroll
  for (int i = 0; i < 4; ++i) {
    const u16* pa = la.p + (k0 + 64 * i * la.ld);
    glds16(pa + offA, buf + (tid + 512 * i) * 16);
  }
#pragma unroll
  for (int i = 0; i < 4; ++i) {
    const u16* pb = lb.p + (k0 + 64 * i * lb.ld);
    glds16(pb + offB, buf + 32768 + (tid + 512 * i) * 16);
  }
}
#define LGKM_WAIT3(N, a, b, c) asm volatile("s_waitcnt lgkmcnt(" #N ")" : "+v"(a), "+v"(b), "+v"(c) :: "memory")
#define LGKM_WAIT1(N, a) asm volatile("s_waitcnt lgkmcnt(" #N ")" : "+v"(a) :: "memory")
template <class LA, class LB>
DI void gemm_mainloop8(f32x16 (&acc)[4][2], const LA& la, const LB& lb, int K, char* smem, int tid) {
  const int lane = tid & 63, w = tid >> 6, wm = w >> 2, wn = w & 3;
  const int n = lane & 31, h = lane >> 5;
  const int nk = K >> 6;
  const int row0 = tid >> 3, ch0 = (tid & 7) ^ ((row0 >> 1) & 7);
  const uint32_t offA = (uint32_t)(row0 * la.ld + ch0 * 8), offB = (uint32_t)(row0 * lb.ld + ch0 * 8);
  const uint32_t sbase = (uint32_t)(size_t)smem;
  const uint32_t fa0 = (uint32_t)swz(wm * 128 + n, h), fb0 = (uint32_t)swz(wn * 64 + n, h);
  gemm_issue8(la, lb, 0, smem, offA, offB, tid);
  asm volatile("s_waitcnt vmcnt(0)" ::: "memory");
  __builtin_amdgcn_s_barrier();
  asm volatile("" ::: "memory");
  if (nk > 1) gemm_issue8(la, lb, 64, smem + STAGE8_BYTES, offA, offB, tid);
  bf16x8 af[4], bfr[2][2];
  lds_rd128<32768>(bfr[0][0], sbase + fb0); lds_rd128<36864>(bfr[0][1], sbase + fb0);
  lds_rd128<0>(af[0], sbase + fa0); lds_rd128<4096>(af[1], sbase + fa0); lds_rd128<8192>(af[2], sbase + fa0); lds_rd128<12288>(af[3], sbase + fa0);
#pragma unroll 1
  for (int kt = 0; kt < nk; ++kt) {
    const uint32_t sb_ = sbase + (uint32_t)((kt & 1) * STAGE8_BYTES);
#pragma unroll
    for (int ks = 0; ks < 3; ++ks) {
      const int cur = ks & 1, nxt = cur ^ 1;
      const uint32_t aa = sb_ + (fa0 ^ (uint32_t)((ks + 1) << 5)), ab = sb_ + (fb0 ^ (uint32_t)((ks + 1) << 5));
      lds_rd128<32768>(bfr[nxt][0], ab); lds_rd128<36864>(bfr[nxt][1], ab);
      LGKM_WAIT3(5, af[0], bfr[cur][0], bfr[cur][1]);
      acc[0][0] = mfma32(af[0], bfr[cur][0], acc[0][0]); acc[0][1] = mfma32(af[0], bfr[cur][1], acc[0][1]);
      lds_rd128<0>(af[0], aa);
      LGKM_WAIT1(5, af[1]);
      acc[1][0] = mfma32(af[1], bfr[cur][0], acc[1][0]); acc[1][1] = mfma32(af[1], bfr[cur][1], acc[1][1]);
      lds_rd128<4096>(af[1], aa);
      LGKM_WAIT1(5, af[2]);
      acc[2][0] = mfma32(af[2], bfr[cur][0], acc[2][0]); acc[2][1] = mfma32(af[2], bfr[cur][1], acc[2][1]);
      lds_rd128<8192>(af[2], aa);
      LGKM_WAIT1(5, af[3]);
      acc[3][0] = mfma32(af[3], bfr[cur][0], acc[3][0]); acc[3][1] = mfma32(af[3], bfr[cur][1], acc[3][1]);
      lds_rd128<12288>(af[3], aa);
    }
    asm volatile("s_waitcnt lgkmcnt(0)" : "+v"(af[0]), "+v"(af[1]), "+v"(af[2]), "+v"(af[3]), "+v"(bfr[1][0]), "+v"(bfr[1][1]) :: "memory");
    const bool more = (kt + 1 < nk);
    const uint32_t sn = sbase + (uint32_t)(((kt + 1) & 1) * STAGE8_BYTES);
    if (more) {
      asm volatile("s_waitcnt vmcnt(0)" ::: "memory");
      __builtin_amdgcn_s_barrier();
      asm volatile("" ::: "memory");
      if (kt + 2 < nk) gemm_issue8(la, lb, (kt + 2) * 64, smem + (kt & 1) * STAGE8_BYTES, offA, offB, tid);
      lds_rd128<32768>(bfr[0][0], sn + fb0); lds_rd128<36864>(bfr[0][1], sn + fb0);
    }
    acc[0][0] = mfma32(af[0], bfr[1][0], acc[0][0]); acc[0][1] = mfma32(af[0], bfr[1][1], acc[0][1]);
    if (more) lds_rd128<0>(af[0], sn + fa0);
    acc[1][0] = mfma32(af[1], bfr[1][0], acc[1][0]); acc[1][1] = mfma32(af[1], bfr[1][1], acc[1][1]);
    if (more) lds_rd128<4096>(af[1], sn + fa0);
    acc[2][0] = mfma32(af[2], bfr[1][0], acc[2][0]); acc[2][1] = mfma32(af[2], bfr[1][1], acc[2][1]);
    if (more) lds_rd128<8192>(af[2], sn + fa0);
    acc[3][0] = mfma32(af[3], bfr[1][0], acc[3][0]); acc[3][1] = mfma32(af[3], bfr[1][1], acc[3][1]);
    if (more) lds_rd128<12288>(af[3], sn + fa0);
  }
  __syncthreads();
}
typedef __attribute__((ext_vector_type(4))) float f32x4a;
DI f32x4a mfma16(bf16x8 a, bf16x8 b, f32x4a c) { return __builtin_amdgcn_mfma_f32_16x16x32_bf16(a, b, c, 0, 0, 0); }
#define X_RDA(MI, ADDR) lds_rd128<(MI) * 2048>(am[MI], ADDR)
#define X_RDB(BUF, ADDR) { lds_rd128<32768>(bq[BUF][0], ADDR); lds_rd128<32768 + 2048>(bq[BUF][1], ADDR); lds_rd128<32768 + 4096>(bq[BUF][2], ADDR); lds_rd128<32768 + 6144>(bq[BUF][3], ADDR); }
#define X_MMA(MI, BUF) { acc[MI][0] = mfma16(am[MI], bq[BUF][0], acc[MI][0]); acc[MI][1] = mfma16(am[MI], bq[BUF][1], acc[MI][1]); \
                         acc[MI][2] = mfma16(am[MI], bq[BUF][2], acc[MI][2]); acc[MI][3] = mfma16(am[MI], bq[BUF][3], acc[MI][3]); }
#define X_WAIT1(N, A) asm volatile("s_waitcnt lgkmcnt(" #N ")" : "+v"(A) :: "memory")
#define X_STEP0(MI) { X_WAIT1(11, am[MI]); X_MMA(MI, 0) X_RDA(MI, a1); }
#define X_STEP1(MI) { X_MMA(MI, 1) if (more) X_RDA(MI, an); }
template <class LA, class LB>
DI void gemm_mainloop8x(f32x4a (&acc)[8][4], const LA& la, const LB& lb, int K, char* smem, int tid) {
  const int lane = tid & 63, w = tid >> 6, wm = w >> 2, wn = w & 3;
  const int r16 = lane & 15, q4 = lane >> 4;
  const int nk = K >> 6;
  const int row0 = tid >> 3, ch0 = (tid & 7) ^ ((row0 >> 1) & 7);
  const uint32_t offA = (uint32_t)(row0 * la.ld + ch0 * 8), offB = (uint32_t)(row0 * lb.ld + ch0 * 8);
  const uint32_t sbase = (uint32_t)(size_t)smem;
  const uint32_t fa0 = (uint32_t)swz(wm * 128 + r16, q4), fb0 = (uint32_t)swz(wn * 64 + r16, q4);
  gemm_issue8(la, lb, 0, smem, offA, offB, tid);
  asm volatile("s_waitcnt vmcnt(0)" ::: "memory");
  __builtin_amdgcn_s_barrier();
  asm volatile("" ::: "memory");
  if (nk > 1) gemm_issue8(la, lb, 64, smem + STAGE8_BYTES, offA, offB, tid);
  bf16x8 am[8], bq[2][4];
  X_RDB(0, sbase + fb0)
  X_RDA(0, sbase + fa0); X_RDA(1, sbase + fa0); X_RDA(2, sbase + fa0); X_RDA(3, sbase + fa0);
  X_RDA(4, sbase + fa0); X_RDA(5, sbase + fa0); X_RDA(6, sbase + fa0); X_RDA(7, sbase + fa0);
#pragma unroll 1
  for (int kt = 0; kt < nk; ++kt) {
    const uint32_t sb_ = sbase + (uint32_t)((kt & 1) * STAGE8_BYTES);
    const uint32_t a1 = sb_ + (fa0 ^ 64u), b1 = sb_ + (fb0 ^ 64u);
    asm volatile("s_waitcnt lgkmcnt(7)" : "+v"(bq[0][0]), "+v"(bq[0][1]), "+v"(bq[0][2]), "+v"(bq[0][3]), "+v"(am[0]) :: "memory");
    X_RDB(1, b1)
    X_MMA(0, 0) X_RDA(0, a1);
    X_STEP0(1) X_STEP0(2) X_STEP0(3) X_STEP0(4) X_STEP0(5) X_STEP0(6) X_STEP0(7)
    asm volatile("s_waitcnt lgkmcnt(0)" : "+v"(bq[1][0]), "+v"(bq[1][1]), "+v"(bq[1][2]), "+v"(bq[1][3]),
                 "+v"(am[0]), "+v"(am[1]), "+v"(am[2]), "+v"(am[3]), "+v"(am[4]), "+v"(am[5]), "+v"(am[6]), "+v"(am[7]) :: "memory");
    const bool more = (kt + 1 < nk);
    const uint32_t sn = sbase + (uint32_t)(((kt + 1) & 1) * STAGE8_BYTES);
    const uint32_t an = sn + fa0;
    if (more) {
      asm volatile("s_waitcnt vmcnt(0)" ::: "memory");
      __builtin_amdgcn_s_barrier();
      asm volatile("" ::: "memory");
      if (kt + 2 < nk) gemm_issue8(la, lb, (kt + 2) * 64, smem + (kt & 1) * STAGE8_BYTES, offA, offB, tid);
      X_RDB(0, sn + fb0)
    }
    X_STEP1(0) X_STEP1(1) X_STEP1(2) X_STEP1(3) X_STEP1(4) X_STEP1(5) X_STEP1(6) X_STEP1(7)
  }
  __syncthreads();
}
DI void zero_acc16(f32x4a (&acc)[8][4]) {
#pragma unroll
  for (int a = 0; a < 8; ++a)
#pragma unroll
    for (int b = 0; b < 4; ++b) acc[a][b] = f32x4a{0.f, 0.f, 0.f, 0.f};
}
DI void stage_half16(const f32x4a (&acc)[8][4], float* Cs, int tid, int bj) {
  const int lane = tid & 63, w = tid >> 6, wm = w >> 2, wn = w & 3;
  if ((wn >> 1) == bj) {
#pragma unroll
    for (int mi = 0; mi < 8; ++mi)
#pragma unroll
      for (int ni = 0; ni < 4; ++ni)
#pragma unroll
        for (int r = 0; r < 4; ++r)
          Cs[(wm * 128 + mi * 16 + (lane >> 4) * 4 + r) * 132 + (wn & 1) * 64 + ni * 16 + (lane & 15)] = acc[mi][ni][r];
  }
}
DI void zero_acc8(f32x16 (&acc)[4][2]) {
#pragma unroll
  for (int a = 0; a < 4; ++a)
#pragma unroll
    for (int b = 0; b < 2; ++b) acc[a][b] = zero16();
}

constexpr int CLD = 132;
DI void stage_half(const f32x16 (&acc)[4][2], float* Cs, int tid, int bj) {
  const int lane = tid & 63, w = tid >> 6, wm = w >> 2, wn = w & 3;
  const int n = lane & 31, h = lane >> 5;
  if ((wn >> 1) == bj) {
#pragma unroll
    for (int mi = 0; mi < 4; ++mi)
#pragma unroll
      for (int ni = 0; ni < 2; ++ni)
#pragma unroll
        for (int r = 0; r < 16; ++r) {
          int row = wm * 128 + mi * 32 + (r & 3) + 8 * (r >> 2) + 4 * h;
          int col = (wn & 1) * 64 + ni * 32 + n;
          Cs[row * CLD + col] = acc[mi][ni][r];
        }
  }
}
DI void stage_acc(const f32x16 (&acc)[2][2], float* Cs, int tid) {
  const int lane = tid & 63, w = tid >> 6, wm = w >> 1, wn = w & 1;
  const int n = lane & 31, h = lane >> 5;
#pragma unroll
  for (int mi = 0; mi < 2; ++mi)
#pragma unroll
    for (int ni = 0; ni < 2; ++ni)
#pragma unroll
      for (int r = 0; r < 16; ++r) {
        int row = wm * 64 + mi * 32 + (r & 3) + 8 * (r >> 2) + 4 * h;
        int col = wn * 64 + ni * 32 + n;
        Cs[row * CLD + col] = acc[mi][ni][r];
      }
}

template <int HD, bool NORM>
DI void epi_rowmajor(const float* Cs, u16* base, int H, int head0, const float* gain, float scale, int r, int SL, int tok0, int tid) {
  const int cc = tid & 15, c8 = cc * 8, hl = c8 / HD, d0 = c8 % HD;
  float g[8];
#pragma unroll
  for (int j = 0; j < 8; ++j) g[j] = NORM ? gain[d0 + j] * scale : scale;
  const int Lr = SL / r;
#pragma unroll 2
  for (int pass = 0; pass < 8; ++pass) {
    int row = (tid >> 4) + 32 * pass;
    float v[8];
    float4 v0 = *reinterpret_cast<const float4*>(Cs + row * CLD + c8);
    float4 v1 = *reinterpret_cast<const float4*>(Cs + row * CLD + c8 + 4);
    v[0] = v0.x; v[1] = v0.y; v[2] = v0.z; v[3] = v0.w; v[4] = v1.x; v[5] = v1.y; v[6] = v1.z; v[7] = v1.w;
    if (NORM) {
      float ss = 0.f;
#pragma unroll
      for (int j = 0; j < 8; ++j) ss += v[j] * v[j];
      ss += __shfl_xor(ss, 1); ss += __shfl_xor(ss, 2); ss += __shfl_xor(ss, 4);
      if (HD == 128) ss += __shfl_xor(ss, 8);
      float rstd = rsqrtf(ss * (1.f / HD) + 1e-6f);
#pragma unroll
      for (int j = 0; j < 8; ++j) v[j] *= rstd * g[j];
    } else {
#pragma unroll
      for (int j = 0; j < 8; ++j) v[j] *= g[j];
    }
    int token = tok0 + row, b = token / SL, t = token % SL;
    int pp = (t % r) * Lr + t / r;
    u16* dst = base + ((size_t)(b * H + head0 + hl) * SL + pp) * HD + d0;
    *reinterpret_cast<uint4*>(dst) = pack8(v);
  }
}
template <int HD, bool BLOCKED>
DI void epi_transposed(const float* Cs, u16* base, int H, int head0, int r, int SL, int tok0, int tid) {
  const int b = tok0 / SL, t0 = tok0 % SL, Lr = SL / r;
#pragma unroll 2
  for (int pass = 0; pass < 8; ++pass) {
    int u = tid + 512 * pass, col = u & 127, cj = u >> 7, c = cj % r, j = cj / r;
    float v[8];
#pragma unroll
    for (int e = 0; e < 8; ++e) v[e] = Cs[(c + r * (8 * j + e)) * CLD + col];
    int hl = col / HD, d = col % HD;
    int pp = c * Lr + t0 / r + 8 * j;
    u16* dst = BLOCKED ? base + ((size_t)(b * H + head0 + hl) * (SL >> 5) + (pp >> 5)) * (HD * 32) + d * 32 + (pp & 31)
                       : base + ((size_t)(b * H + head0 + hl) * HD + d) * SL + pp;
    *reinterpret_cast<uint4*>(dst) = pack8(v);
  }
}

DI void transpose_tile(const float* src, int N, u16* dst, int dst_ld, int tk, int tn, float* tile) {
  const int tid = threadIdx.x;
#pragma unroll
  for (int i = 0; i < 2; ++i) {
    int r = (tid >> 4) + 32 * i, c4 = (tid & 15) * 4;
    float4 v = *reinterpret_cast<const float4*>(src + (size_t)(tk * 64 + r) * N + tn * 64 + c4);
    tile[r * 65 + c4] = v.x; tile[r * 65 + c4 + 1] = v.y; tile[r * 65 + c4 + 2] = v.z; tile[r * 65 + c4 + 3] = v.w;
  }
  __syncthreads();
  {
    int nn = (tid >> 3), kc = (tid & 7) * 8;
    float v[8];
#pragma unroll
    for (int j = 0; j < 8; ++j) v[j] = tile[(kc + j) * 65 + nn];
    *reinterpret_cast<uint4*>(dst + (size_t)(tn * 64 + nn) * dst_ld + tk * 64 + kc) = pack8(v);
  }
  __syncthreads();
}
DI void rmsnorm_row(const float* src, const float* gain, u16* dst) {
  const int lane = threadIdx.x & 63;
  float4 v[4];
  float ss = 0.f;
#pragma unroll
  for (int i = 0; i < 4; ++i) {
    v[i] = *reinterpret_cast<const float4*>(src + i * 256 + lane * 4);
    ss += v[i].x * v[i].x + v[i].y * v[i].y + v[i].z * v[i].z + v[i].w * v[i].w;
  }
  ss = wave_sum(ss);
  float rstd = rsqrtf(ss * (1.f / 1024.f) + 1e-6f);
#pragma unroll
  for (int i = 0; i < 4; ++i) {
    float4 g = *reinterpret_cast<const float4*>(gain + i * 256 + lane * 4);
    uint2 o; o.x = pack2(v[i].x * rstd * g.x, v[i].y * rstd * g.y); o.y = pack2(v[i].z * rstd * g.z, v[i].w * rstd * g.w);
    *reinterpret_cast<uint2*>(dst + i * 256 + lane * 4) = o;
  }
}
DI void fp8_row(const float* src, unsigned char* dst, float* inv_scale) {
  const int lane = threadIdx.x & 63;
  float4 v[4];
  float am = 0.f;
#pragma unroll
  for (int i = 0; i < 4; ++i) {
    v[i] = *reinterpret_cast<const float4*>(src + lane * 16 + i * 4);
    am = fmaxf(am, fmaxf(fmaxf(fabsf(v[i].x), fabsf(v[i].y)), fmaxf(fabsf(v[i].z), fabsf(v[i].w))));
  }
#pragma unroll
  for (int o = 32; o; o >>= 1) am = fmaxf(am, __shfl_xor(am, o));
  float e = (am > 0.f) ? floorf(log2f(256.f / am)) : 0.f;
  e = fminf(fmaxf(e, -100.f), 100.f);
  const float sc = exp2f(e);
  uint4 o;
  unsigned* ow = reinterpret_cast<unsigned*>(&o);
#pragma unroll
  for (int i = 0; i < 4; ++i) {
    int w = __builtin_amdgcn_cvt_pk_fp8_f32(v[i].x * sc, v[i].y * sc, 0, false);
    w = __builtin_amdgcn_cvt_pk_fp8_f32(v[i].z * sc, v[i].w * sc, w, true);
    ow[i] = (unsigned)w;
  }
  *reinterpret_cast<uint4*>(dst + lane * 16) = o;
  if (lane == 0) *inv_scale = exp2f(-e);
}
DI void rmsnorm_row2(const float* s0, const float* g0, u16* d0, const float* s1, const float* g1, u16* d1) {
  const int lane = threadIdx.x & 63;
  float4 a[4], b[4];
#pragma unroll
  for (int i = 0; i < 4; ++i) { a[i] = *reinterpret_cast<const float4*>(s0 + i * 256 + lane * 4); b[i] = *reinterpret_cast<const float4*>(s1 + i * 256 + lane * 4); }
  float sa = 0.f, sb = 0.f;
#pragma unroll
  for (int i = 0; i < 4; ++i) {
    sa += a[i].x * a[i].x + a[i].y * a[i].y + a[i].z * a[i].z + a[i].w * a[i].w;
    sb += b[i].x * b[i].x + b[i].y * b[i].y + b[i].z * b[i].z + b[i].w * b[i].w;
  }
#pragma unroll
  for (int o = 32; o; o >>= 1) { sa += __shfl_xor(sa, o); sb += __shfl_xor(sb, o); }
  const float ra = rsqrtf(sa * (1.f / 1024.f) + 1e-6f), rb = rsqrtf(sb * (1.f / 1024.f) + 1e-6f);
#pragma unroll
  for (int i = 0; i < 4; ++i) {
    float4 ga = *reinterpret_cast<const float4*>(g0 + i * 256 + lane * 4);
    float4 gb = *reinterpret_cast<const float4*>(g1 + i * 256 + lane * 4);
    uint2 o; o.x = pack2(a[i].x * ra * ga.x, a[i].y * ra * ga.y); o.y = pack2(a[i].z * ra * ga.z, a[i].w * ra * ga.w);
    *reinterpret_cast<uint2*>(d0 + i * 256 + lane * 4) = o;
    o.x = pack2(b[i].x * rb * gb.x, b[i].y * rb * gb.y); o.y = pack2(b[i].z * rb * gb.z, b[i].w * rb * gb.w);
    *reinterpret_cast<uint2*>(d1 + i * 256 + lane * 4) = o;
  }
}
DI void fp8_row2(const float* s0, unsigned char* d0, float* i0, const float* s1, unsigned char* d1, float* i1) {
  const int lane = threadIdx.x & 63;
  float4 a[4], b[4];
#pragma unroll
  for (int i = 0; i < 4; ++i) { a[i] = *reinterpret_cast<const float4*>(s0 + lane * 16 + i * 4); b[i] = *reinterpret_cast<const float4*>(s1 + lane * 16 + i * 4); }
  float ma = 0.f, mb = 0.f;
#pragma unroll
  for (int i = 0; i < 4; ++i) {
    ma = fmaxf(ma, fmaxf(fmaxf(fabsf(a[i].x), fabsf(a[i].y)), fmaxf(fabsf(a[i].z), fabsf(a[i].w))));
    mb = fmaxf(mb, fmaxf(fmaxf(fabsf(b[i].x), fabsf(b[i].y)), fmaxf(fabsf(b[i].z), fabsf(b[i].w))));
  }
#pragma unroll
  for (int o = 32; o; o >>= 1) { ma = fmaxf(ma, __shfl_xor(ma, o)); mb = fmaxf(mb, __shfl_xor(mb, o)); }
  float ea = (ma > 0.f) ? floorf(log2f(256.f / ma)) : 0.f, eb = (mb > 0.f) ? floorf(log2f(256.f / mb)) : 0.f;
  ea = fminf(fmaxf(ea, -100.f), 100.f); eb = fminf(fmaxf(eb, -100.f), 100.f);
  const float sca = exp2f(ea), scb = exp2f(eb);
  uint4 oa, ob;
  unsigned* wa = reinterpret_cast<unsigned*>(&oa); unsigned* wb = reinterpret_cast<unsigned*>(&ob);
#pragma unroll
  for (int i = 0; i < 4; ++i) {
    int w = __builtin_amdgcn_cvt_pk_fp8_f32(a[i].x * sca, a[i].y * sca, 0, false);
    w = __builtin_amdgcn_cvt_pk_fp8_f32(a[i].z * sca, a[i].w * sca, w, true);
    wa[i] = (unsigned)w;
    w = __builtin_amdgcn_cvt_pk_fp8_f32(b[i].x * scb, b[i].y * scb, 0, false);
    w = __builtin_amdgcn_cvt_pk_fp8_f32(b[i].z * scb, b[i].w * scb, w, true);
    wb[i] = (unsigned)w;
  }
  *reinterpret_cast<uint4*>(d0 + (size_t)(lane >> 3) * (16384 * 128) + (lane & 7) * 16) = oa;
  *reinterpret_cast<uint4*>(d1 + (size_t)(lane >> 3) * (16384 * 128) + (lane & 7) * 16) = ob;
  if (lane == 0) { *i0 = exp2f(-ea); *i1 = exp2f(-eb); }
}
DI void convert_range(const float* src, u16* dst, size_t n8, size_t start, size_t stride) {
  for (size_t i = start; i < n8; i += stride) {
    float4 a = *reinterpret_cast<const float4*>(src + i * 8);
    float4 b = *reinterpret_cast<const float4*>(src + i * 8 + 4);
    uint4 o; o.x = pack2(a.x, a.y); o.y = pack2(a.z, a.w); o.z = pack2(b.x, b.y); o.w = pack2(b.z, b.w);
    *reinterpret_cast<uint4*>(dst + i * 8) = o;
  }
}

__device__ void phase0(const Params& p, int bid, int nb, char* smem) {
  float* tile = reinterpret_cast<float*>(smem);
  char* ws = p.ws;
  const int NTT = 1088 + 768 + 256 + 128 + 64 + 128 + 256 + 512;
  for (int it = bid; it < NTT; it += nb) {
    int i = it;
    const float* src; int N; u16* dst; int ld;
    if (i < 1088) { src = p.w_in; N = 4352; dst = (u16*)(ws + OFF_WINT); ld = 1024; }
    else if ((i -= 1088) < 768) { src = p.w_gate; N = 3072; dst = (u16*)(ws + OFF_WGT); ld = 1024; }
    else if ((i -= 768) < 256) { src = p.w_mem_kv; N = 1024; dst = (u16*)(ws + OFF_WKVT); ld = 1024; }
    else if ((i -= 256) < 128) { src = p.w_o_sb; N = 1024; dst = (u16*)(ws + OFF_WOT); ld = 1280; }
    else if ((i -= 128) < 64) { src = p.w_o_dil; N = 1024; dst = (u16*)(ws + OFF_WOT) + 512; ld = 1280; }
    else if ((i -= 64) < 128) { src = p.w_o_mem; N = 1024; dst = (u16*)(ws + OFF_WOT) + 768; ld = 1280; }
    else if ((i -= 128) < 256) { src = p.w_out; N = 1024; dst = (u16*)(ws + OFF_WOUTT); ld = 1024; }
    else { i -= 256; src = p.w_peer_q; N = 2048; dst = (u16*)(ws + OFF_WPQT); ld = 1024; }
    int ntn = N / 64;
    transpose_tile(src, N, dst, ld, i / ntn, i % ntn, tile);
  }
  const int w = __builtin_amdgcn_readfirstlane(threadIdx.x >> 6);
  u16* hbf = (u16*)((char*)p.out + OUT_OFF_H);
  u16* memh = (u16*)((char*)p.out + OUT_OFF_MEMH);
  {
    const int stride = nb * WPB;
    for (int row = bid * WPB + w; row < T_ + 2048; row += 2 * stride) {
      const int r1 = row + stride;
      const float* s0 = (row < T_) ? p.x + (size_t)row * 1024 : p.mem + (size_t)(row - T_) * 1024;
      const float* g0 = (row < T_) ? p.g_mix : p.g_mem;
      u16* d0 = (row < T_) ? hbf + (size_t)row * 1024 : memh + (size_t)(row - T_) * 1024;
      if (r1 < T_ + 2048) {
        const float* s1 = (r1 < T_) ? p.x + (size_t)r1 * 1024 : p.mem + (size_t)(r1 - T_) * 1024;
        const float* g1 = (r1 < T_) ? p.g_mix : p.g_mem;
        u16* d1 = (r1 < T_) ? hbf + (size_t)r1 * 1024 : memh + (size_t)(r1 - T_) * 1024;
        rmsnorm_row2(s0, g0, d0, s1, g1, d1);
      } else rmsnorm_row(s0, g0, d0);
    }
  }
  convert_range(p.subkeys, (u16*)(ws + OFF_SUBK), 262144 / 8, (size_t)bid * NTHR + threadIdx.x, (size_t)nb * NTHR);
  float* usc = (float*)(ws + OFF_USC);
  for (int row = bid * WPB + w; row < 16384; row += nb * WPB)
    fp8_row2(p.peer_u + (size_t)row * 1024, (unsigned char*)(ws + OFF_U8) + (size_t)row * 128, usc + row * 2,
             p.peer_v + (size_t)row * 1024, (unsigned char*)(ws + OFF_V8) + (size_t)row * 128, usc + row * 2 + 1);
}

DI void p1_epilogue(const Params& p, char* ws, const float* Cs, int c0, int tok0, int kv, int tid) {
  if (!kv) {
    if (c0 < 512) epi_rowmajor<64, false>(Cs, (u16*)(ws + OFF_QSB), 8, c0 / 64, nullptr, 0.125f, 1, 2048, tok0, tid);
    else if (c0 < 1024) epi_rowmajor<64, false>(Cs, (u16*)(ws + OFF_KSB), 8, (c0 - 512) / 64, nullptr, 1.f, 1, 2048, tok0, tid);
    else if (c0 < 1536) epi_transposed<64, true>(Cs, (u16*)(ws + OFF_VTSB), 8, (c0 - 1024) / 64, 1, 2048, tok0, tid);
    else if (c0 < 2304) { int h0 = (c0 - 1536) / 64; epi_rowmajor<64, true>(Cs, (u16*)(ws + OFF_QD), 12, h0, p.g_q_dil, 0.125f, 1 << (2 * (h0 >> 2)), 2048, tok0, tid); }
    else if (c0 < 3072) { int h0 = (c0 - 2304) / 64; epi_rowmajor<64, true>(Cs, (u16*)(ws + OFF_KD), 12, h0, p.g_k_dil, 1.f, 1 << (2 * (h0 >> 2)), 2048, tok0, tid); }
    else if (c0 < 3840) { int h0 = (c0 - 3072) / 64; epi_transposed<64, true>(Cs, (u16*)(ws + OFF_VTD), 12, h0, 1 << (2 * (h0 >> 2)), 2048, tok0, tid); }
    else epi_rowmajor<128, true>(Cs, (u16*)(ws + OFF_QM), 4, (c0 - 3840) / 128, p.g_q_mem, 0.08838834764831845f, 1, 2048, tok0, tid);
  } else {
    if (c0 < 512) epi_rowmajor<128, true>(Cs, (u16*)(ws + OFF_KM), 4, c0 / 128, p.g_k_mem, 1.f, 1, 256, tok0, tid);
    else epi_transposed<128, false>(Cs, (u16*)(ws + OFF_VTM), 4, (c0 - 512) / 128, 1, 256, tok0, tid);
  }
}
__device__ void phase1(const Params& p, int bid, int nb, char* smem) {
  char* ws = p.ws;
  float* Cs = reinterpret_cast<float*>(smem);
  const u16* hbf = (const u16*)((char*)p.out + OUT_OFF_H);
  const u16* memh = (const u16*)((char*)p.out + OUT_OFF_MEMH);
  const int xcd = bid & 7, lb = bid >> 3, nlb = (nb + 7 - xcd) >> 3;
  for (int li = lb; li < 128; li += nlb) {
    const int tid = launder(threadIdx.x);
    f32x4a acc[8][4];
    zero_acc16(acc);
    const int tm = li >> 1, tn = 2 * xcd + (li & 1);
    gemm_mainloop8x(acc, LdPlain{hbf + (size_t)tm * 256 * 1024, 1024}, LdPlain{(const u16*)(ws + OFF_WINT) + (size_t)tn * 256 * 1024, 1024}, 1024, smem, tid);
#pragma unroll 1
    for (int bj = 0; bj < 2; ++bj) {
      stage_half16(acc, Cs, tid, bj);
      __syncthreads();
      p1_epilogue(p, ws, Cs, tn * 256 + bj * 128, tm * 256, 0, tid);
      __syncthreads();
    }
  }
  for (int hi = lb; hi < 24; hi += nlb) {
    const int tid = launder(threadIdx.x);
    f32x16 acc[2][2];
#pragma unroll
    for (int a = 0; a < 2; ++a)
#pragma unroll
      for (int b = 0; b < 2; ++b) acc[a][b] = zero16();
    int kv, tm, c0;
    if (hi < 16) { kv = 0; tm = 8 * xcd + (hi >> 1); c0 = 16 * 256 + (hi & 1) * 128; }
    else { kv = 1; tm = xcd; c0 = (hi - 16) * 128; }
    if (!kv) gemm_mainloop(acc, LdPlain{hbf + (size_t)tm * 256 * 1024, 1024}, LdPlain{(const u16*)(ws + OFF_WINT) + (size_t)c0 * 1024, 1024}, 1024, smem, tid);
    else gemm_mainloop(acc, LdPlain{memh + (size_t)tm * 256 * 1024, 1024}, LdPlain{(const u16*)(ws + OFF_WKVT) + (size_t)c0 * 1024, 1024}, 1024, smem, tid);
    stage_acc(acc, Cs, tid);
    __syncthreads();
    p1_epilogue(p, ws, Cs, c0, tm * 256, kv, tid);
    __syncthreads();
  }
}

DI void pack_p(const float* a, bf16x8& p0, bf16x8& p1) {
  uint4 u0 = pack8(a), u1 = pack8(a + 8);
  p0 = as_bf16x8(u0); p1 = as_bf16x8(u1);
}
DI void write_ot(const f32x16& o, float scale, u16* rowp, int db, int h) {
#pragma unroll
  for (int g = 0; g < 4; ++g) {
    uint2 v; v.x = pack2(o[4 * g] * scale, o[4 * g + 1] * scale); v.y = pack2(o[4 * g + 2] * scale, o[4 * g + 3] * scale);
    *reinterpret_cast<uint2*>(rowp + 32 * db + 8 * g + 4 * h) = v;
  }
}

#define KV_DECL uint4 sk0, sk1, sk2, sk3, sv0, sv1, sv2, sv3;
#define KV_FETCH(Kb, Vb, key0) { \
    const char* kp_ = reinterpret_cast<const char*>(Kb) + (uint32_t)((key0) * 128 + lane * 16); \
    const char* vp_ = reinterpret_cast<const char*>(Vb) + (uint32_t)(((key0) >> 5) * 4096 + lane * 16); \
    sk0 = *reinterpret_cast<const uint4*>(kp_); sk1 = *reinterpret_cast<const uint4*>(kp_ + 1024); \
    sk2 = *reinterpret_cast<const uint4*>(kp_ + 2048); sk3 = *reinterpret_cast<const uint4*>(kp_ + 3072); \
    sv0 = *reinterpret_cast<const uint4*>(vp_); sv1 = *reinterpret_cast<const uint4*>(vp_ + 1024); \
    sv2 = *reinterpret_cast<const uint4*>(vp_ + 2048); sv3 = *reinterpret_cast<const uint4*>(vp_ + 3072); }
#define KV_PARK(lk) { \
    char* lv_ = (lk) + 4096; const int kr_ = lane >> 3, kc_ = lane & 7, vd_ = lane >> 2, vq_ = lane & 3; \
    *reinterpret_cast<uint4*>((lk) + swz(kr_, kc_)) = sk0; *reinterpret_cast<uint4*>((lk) + swz(kr_ + 8, kc_)) = sk1; \
    *reinterpret_cast<uint4*>((lk) + swz(kr_ + 16, kc_)) = sk2; *reinterpret_cast<uint4*>((lk) + swz(kr_ + 24, kc_)) = sk3; \
    *reinterpret_cast<uint4*>(lv_ + vd_ * 64 + ((vq_ ^ ((vd_ >> 2) & 3)) << 4)) = sv0; \
    *reinterpret_cast<uint4*>(lv_ + (vd_ + 16) * 64 + ((vq_ ^ (((vd_ + 16) >> 2) & 3)) << 4)) = sv1; \
    *reinterpret_cast<uint4*>(lv_ + (vd_ + 32) * 64 + ((vq_ ^ (((vd_ + 32) >> 2) & 3)) << 4)) = sv2; \
    *reinterpret_cast<uint4*>(lv_ + (vd_ + 48) * 64 + ((vq_ ^ (((vd_ + 48) >> 2) & 3)) << 4)) = sv3; }
DI void kv_frags(bf16x8 (&kf)[4], bf16x8 (&vf)[2][2], const char* lk, int pin, int n, int h) {
  const char* lv = lk + 4096;
#pragma unroll
  for (int ks = 0; ks < 4; ++ks) kf[ks] = *reinterpret_cast<const bf16x8*>(lk + swz(pin, 4 * h + ks));
#pragma unroll
  for (int db = 0; db < 2; ++db)
#pragma unroll
    for (int s = 0; s < 2; ++s) {
      const int d = 32 * db + n;
      vf[db][s] = *reinterpret_cast<const bf16x8*>(lv + d * 64 + (((2 * s + h) ^ ((d >> 2) & 3)) << 4));
    }
}

__device__ void sb_task(const char* ws, char* outb, char* lk, int b, int hd, int qt) {
  const int lane = threadIdx.x & 63, n = lane & 31, h = lane >> 5;
  const u16* Qb = (const u16*)(ws + OFF_QSB) + (size_t)(b * 8 + hd) * 2048 * 64;
  const u16* Kb = (const u16*)(ws + OFF_KSB) + (size_t)(b * 8 + hd) * 2048 * 64;
  const u16* Vb = (const u16*)(ws + OFF_VTSB) + (size_t)(b * 8 + hd) * 64 * 2048;
  const int q0 = qt * 32;
  bf16x8 qf[4];
#pragma unroll
  for (int ks = 0; ks < 4; ++ks) qf[ks] = ld16(Qb + (uint32_t)((q0 + n) * 64 + 32 * h + 8 * ks));
  f32x16 o0 = zero16(), o1 = zero16();
  float carry = 0.f;
  const int pin = pi32(n);
  KV_DECL
  KV_FETCH(Kb, Vb, q0)
  for (int kb = qt; kb >= 0; --kb) {
    KV_PARK(lk)
    KV_FETCH(Kb, Vb, (kb > 0 ? kb - 1 : 0) * 32)
    bf16x8 kf[4], vf[2][2];
    kv_frags(kf, vf, lk, pin, n, h);
    f32x16 z = zero16();
#pragma unroll
    for (int ks = 0; ks < 4; ++ks) z = mfma32(kf[ks], qf[ks], z);
    const bool diag = (kb == qt);
    float sp[16], E[16];
#pragma unroll
    for (int r = 0; r < 16; ++r) {
      int kl = 16 * (r >> 3) + 8 * h + (r & 7);
      bool valid = (!diag) || (kl < n);
      float zz = z[r];
      float e = __expf(-fabsf(zz));
      float s = fmaxf(zz, 0.f) + __logf(1.f + e);
      sp[r] = valid ? s : 0.f;
    }
    E[7] = 0.f; E[15] = 0.f;
#pragma unroll
    for (int r = 6; r >= 0; --r) { E[r] = E[r + 1] + sp[r + 1]; E[r + 8] = E[r + 9] + sp[r + 9]; }
    float A0 = E[0] + sp[0], A1 = E[8] + sp[8];
    float B0 = __shfl_xor(A0, 32), B1 = __shfl_xor(A1, 32);
    float after0 = h ? (B1 + A1) : (B0 + A1 + B1);
    float after1 = h ? 0.f : B1;
    float a[16];
#pragma unroll
    for (int r = 0; r < 16; ++r) {
      int kl = 16 * (r >> 3) + 8 * h + (r & 7);
      bool valid = (!diag) || (kl < n);
      float bet = carry + ((r < 8) ? after0 : after1) + E[r];
      float v = __expf(z[r] - sp[r] - bet);
      a[r] = valid ? v : 0.f;
    }
    carry += A0 + A1 + B0 + B1;
    bf16x8 p0, p1;
    pack_p(a, p0, p1);
    o0 = mfma32(vf[0][0], p0, o0); o0 = mfma32(vf[0][1], p1, o0);
    o1 = mfma32(vf[1][0], p0, o1); o1 = mfma32(vf[1][1], p1, o1);
    if (__all(carry > 104.f)) break;
  }
  u16* rowp = (u16*)(outb + OUT_OFF_YSB) + (size_t)(b * 2048 + q0 + n) * 512 + hd * 64;
  write_ot(o0, 1.f, rowp, 0, h);
  write_ot(o1, 1.f, rowp, 1, h);
}

__device__ void dil_task(const char* ws, char* outb, char* lk, int b, int head, int pt) {
  const int lane = threadIdx.x & 63, n = lane & 31, h = lane >> 5;
  const int g = head >> 2, r_ = 1 << (2 * g), L = 2048 / r_;
  const int p0 = pt * 32, c = p0 / L, i0 = p0 % L;
  const float slope = exp2f(-8.f * (float)(head + 1) / 12.f) * (float)r_;
  const u16* Qb = (const u16*)(ws + OFF_QD) + (size_t)(b * 12 + head) * 2048 * 64;
  const u16* Kb = (const u16*)(ws + OFF_KD) + (size_t)(b * 12 + head) * 2048 * 64;
  const u16* Vb = (const u16*)(ws + OFF_VTD) + (size_t)(b * 12 + head) * 64 * 2048;
  bf16x8 qf[4];
#pragma unroll
  for (int ks = 0; ks < 4; ++ks) qf[ks] = ld16(Qb + (uint32_t)((p0 + n) * 64 + 32 * h + 8 * ks));
  f32x16 o0 = zero16(), o1 = zero16();
  float m = -1e30f, lsum = 0.f;
  const int pin = pi32(n);
  KV_DECL
  KV_FETCH(Kb, Vb, p0)
  for (int rel = 0; rel >= -4; --rel) {
    const int ib = i0 + 32 * rel;
    if (ib < 0) break;
    KV_PARK(lk)
    KV_FETCH(Kb, Vb, c * L + ((ib >= 32) ? ib - 32 : ib))
    bf16x8 kf[4], vf[2][2];
    kv_frags(kf, vf, lk, pin, n, h);
    f32x16 z = zero16();
#pragma unroll
    for (int ks = 0; ks < 4; ++ks) z = mfma32(kf[ks], qf[ks], z);
    float s[16];
    float bm = -1e30f;
#pragma unroll
    for (int r = 0; r < 16; ++r) {
      int kl = 16 * (r >> 3) + 8 * h + (r & 7);
      int gap = n - kl - 32 * rel;
      bool valid = (gap >= 0) && (gap <= 128);
      s[r] = valid ? (z[r] - slope * (float)gap) : -1e30f;
      bm = fmaxf(bm, s[r]);
    }
    bm = fmaxf(bm, __shfl_xor(bm, 32));
    float mn = fmaxf(m, bm);
    float alpha = __expf(m - mn);
    float a[16];
    float ps = 0.f;
#pragma unroll
    for (int r = 0; r < 16; ++r) { a[r] = __expf(s[r] - mn); ps += a[r]; }
    lsum = lsum * alpha + ps;
#pragma unroll
    for (int r = 0; r < 16; ++r) { o0[r] *= alpha; o1[r] *= alpha; }
    m = mn;
    bf16x8 p0, p1;
    pack_p(a, p0, p1);
    o0 = mfma32(vf[0][0], p0, o0); o0 = mfma32(vf[0][1], p1, o0);
    o1 = mfma32(vf[1][0], p0, o1); o1 = mfma32(vf[1][1], p1, o1);
  }
  float ltot = lsum + __shfl_xor(lsum, 32);
  float inv = 1.f / ltot;
  int t = c + r_ * (i0 + n);
  size_t token = (size_t)b * 2048 + t;
  u16* rowp = (u16*)(ws + OFF_YD) + (token * 12 + head) * 64;
  write_ot(o0, inv, rowp, 0, h);
  write_ot(o1, inv, rowp, 1, h);
  if (h == 0) ((float*)(outb + OUT_OFF_LSE))[token * 12 + head] = m + __logf(ltot);
}

__device__ void mem_block_task(const char* ws, char* smem, int b, int hm, int qgrp) {
  const int tid = threadIdx.x, lane = tid & 63, w = tid >> 6, n = lane & 31, h = lane >> 5;
  const u16* Qb = (const u16*)(ws + OFF_QM) + (size_t)(b * 4 + hm) * 2048 * 128;
  const char* Kg = ws + OFF_KM + (size_t)(b * 4 + hm) * 256 * 128 * 2;
  const char* Vg = ws + OFF_VTM + (size_t)(b * 4 + hm) * 128 * 256 * 2;
  char* lk = smem;
  char* lv = smem + 65536;
#pragma unroll
  for (int i = 0; i < 8; ++i) {
    const int idx = tid + 512 * i;
    const int kr = idx >> 4, kc = idx & 15;
    const uint4 kv = *reinterpret_cast<const uint4*>(Kg + (uint32_t)idx * 16u);
    const int vd = idx >> 5, vc = idx & 31;
    const uint4 vv = *reinterpret_cast<const uint4*>(Vg + (uint32_t)idx * 16u);
    *reinterpret_cast<uint4*>(lk + kr * 256 + ((kc ^ (kr & 15)) << 4)) = kv;
    *reinterpret_cast<uint4*>(lv + vd * 512 + ((vc ^ (vd & 15)) << 4)) = vv;
  }
  const int q0 = (qgrp * 8 + w) * 32;
  bf16x8 qf[8];
#pragma unroll
  for (int ks = 0; ks < 8; ++ks) qf[ks] = ld16(Qb + (uint32_t)((q0 + n) * 128 + 64 * h + 8 * ks));
  __syncthreads();
  f32x16 o[4];
#pragma unroll
  for (int db = 0; db < 4; ++db) o[db] = zero16();
  float m = -1e30f, lsum = 0.f;
  const int pin = pi32(n);
  for (int kb = 0; kb < 8; ++kb) {
    const int krow = kb * 32 + pin;
    const char* kp = lk + krow * 256;
    f32x16 z = zero16();
#pragma unroll
    for (int ks = 0; ks < 8; ++ks) z = mfma32(*reinterpret_cast<const bf16x8*>(kp + (((8 * h + ks) ^ (krow & 15)) << 4)), qf[ks], z);
    float bm = -1e30f;
#pragma unroll
    for (int r = 0; r < 16; ++r) bm = fmaxf(bm, z[r]);
    bm = fmaxf(bm, __shfl_xor(bm, 32));
    float mn = fmaxf(m, bm);
    float alpha = __expf(m - mn);
    float a[16];
    float ps = 0.f;
#pragma unroll
    for (int r = 0; r < 16; ++r) { a[r] = __expf(z[r] - mn); ps += a[r]; }
    lsum = lsum * alpha + ps;
    m = mn;
    bf16x8 p0, p1;
    pack_p(a, p0, p1);
#pragma unroll
    for (int db = 0; db < 4; ++db) {
      const int d = 32 * db + n;
      const char* vp = lv + d * 512;
      bf16x8 vf0 = *reinterpret_cast<const bf16x8*>(vp + (((4 * kb + h) ^ (d & 15)) << 4));
      bf16x8 vf1 = *reinterpret_cast<const bf16x8*>(vp + (((4 * kb + 2 + h) ^ (d & 15)) << 4));
#pragma unroll
      for (int r = 0; r < 16; ++r) o[db][r] *= alpha;
      o[db] = mfma32(vf0, p0, o[db]);
      o[db] = mfma32(vf1, p1, o[db]);
    }
  }
  float ltot = lsum + __shfl_xor(lsum, 32);
  float inv = 1.f / ltot;
  u16* rowp = (u16*)(ws + OFF_YM) + (size_t)(b * 2048 + q0 + n) * 512 + hm * 128;
#pragma unroll
  for (int db = 0; db < 4; ++db) write_ot(o[db], inv, rowp, db, h);
  __syncthreads();
}

__device__ void phase2(const Params& p, int bid, int nb, char* smem) {
  const char* ws = p.ws;
  const int w = __builtin_amdgcn_readfirstlane(threadIdx.x >> 6);
  const int gw = bid * WPB + w, nw = nb * WPB;
  char* lk = smem + w * 8192;
  for (int bt = bid; bt < 256; bt += nb) mem_block_task(ws, smem, bt >> 5, (bt >> 3) & 3, bt & 7);
  for (int task = gw; task < 4096 + 6144; task += nw) {
    if (task < 4096) {
      int qt = 63 - (task >> 6), bh = task & 63;
      sb_task(ws, (char*)p.out, lk, bh >> 3, bh & 7, qt);
    } else {
      int i = task - 4096;
      int pt = i & 63, bh = i >> 6;
      dil_task(ws, (char*)p.out, lk, bh / 12, bh % 12, pt);
    }
  }
}

__device__ void phase2b(const Params& p, int bid, int nb) {
  char* ws = p.ws;
  const size_t gt = (size_t)bid * NTHR + threadIdx.x, gs = (size_t)nb * NTHR;
  const u16* Yd = (const u16*)(ws + OFF_YD);
  const float* LSE = (const float*)((char*)p.out + OUT_OFF_LSE);
  u16* Ydm = (u16*)((char*)p.out + OUT_OFF_YDM);
  for (size_t i = gt; i < (size_t)T_ * 32; i += gs) {
    size_t t = i >> 5; int c = (int)(i & 31), hg = c >> 3, d0 = (c & 7) * 8;
    float l0 = LSE[t * 12 + hg], l1 = LSE[t * 12 + 4 + hg], l2 = LSE[t * 12 + 8 + hg];
    float mx = fmaxf(l0, fmaxf(l1, l2));
    float e0 = __expf(l0 - mx), e1 = __expf(l1 - mx), e2 = __expf(l2 - mx);
    float inv = 1.f / (e0 + e1 + e2);
    float wg[3] = {e0 * inv, e1 * inv, e2 * inv};
    float acc[8];
#pragma unroll
    for (int j = 0; j < 8; ++j) acc[j] = 0.f;
#pragma unroll
    for (int g = 0; g < 3; ++g) {
      uint4 v = *reinterpret_cast<const uint4*>(Yd + (t * 12 + g * 4 + hg) * 64 + d0);
      acc[0] += wg[g] * bf_lo(v.x); acc[1] += wg[g] * bf_hi(v.x); acc[2] += wg[g] * bf_lo(v.y); acc[3] += wg[g] * bf_hi(v.y);
      acc[4] += wg[g] * bf_lo(v.z); acc[5] += wg[g] * bf_hi(v.z); acc[6] += wg[g] * bf_lo(v.w); acc[7] += wg[g] * bf_hi(v.w);
    }
    *reinterpret_cast<uint4*>(Ydm + t * 256 + c * 8) = pack8(acc);
  }
}

__device__ void phase3(const Params& p, int bid, int nb, char* smem) {
  char* ws = p.ws;
  float* Cs = reinterpret_cast<float*>(smem);
  const u16* hbf = (const u16*)((char*)p.out + OUT_OFF_H);
  const int xcd = bid & 7, lb = bid >> 3, nlb = (nb + 7 - xcd) >> 3;
  for (int li = lb; li < 64; li += nlb) {
    const int tid = launder(threadIdx.x);
    const int lane = tid & 63, w = tid >> 6, wn = w & 1, n = lane & 31;
    const int tm = 8 * xcd + (li >> 3), tn = li & 7;
#pragma unroll 1
    for (int br = 0; br < 3; ++br) {
      f32x16 acc[2][2];
#pragma unroll
      for (int a = 0; a < 2; ++a)
#pragma unroll
        for (int b = 0; b < 2; ++b) acc[a][b] = zero16();
      gemm_mainloop(acc, LdPlain{hbf + (size_t)tm * 256 * 1024, 1024},
                    LdPlain{(const u16*)(ws + OFF_WGT) + (size_t)(br * 1024 + tn * 128) * 1024, 1024}, 1024, smem, tid);
      char* gscr = uniform_ptr(ws + OFF_GSCR + (size_t)bid * (NTHR * 8 * 16));
      const uint32_t toff = (uint32_t)tid * 16u;
#pragma unroll
      for (int mi = 0; mi < 2; ++mi)
#pragma unroll
        for (int ni = 0; ni < 2; ++ni) {
          float bias = p.b_gate[br * 1024 + tn * 128 + wn * 64 + ni * 32 + n];
#pragma unroll
          for (int q4 = 0; q4 < 2; ++q4) {
            uint32_t pk[4];
#pragma unroll
            for (int r = 0; r < 4; ++r) {
              float g0 = __builtin_amdgcn_rcpf(1.f + __expf(-(acc[mi][ni][8 * q4 + 2 * r] + bias)));
              float g1 = __builtin_amdgcn_rcpf(1.f + __expf(-(acc[mi][ni][8 * q4 + 2 * r + 1] + bias)));
              pk[r] = pack2(g0, g1);
            }
            *reinterpret_cast<uint4*>(gscr + ((mi * 2 + ni) * 2 + q4) * (NTHR * 16) + toff) = make_uint4(pk[0], pk[1], pk[2], pk[3]);
            __builtin_amdgcn_sched_barrier(0);
          }
        }
#pragma unroll
      for (int a = 0; a < 2; ++a)
#pragma unroll
        for (int b = 0; b < 2; ++b) acc[a][b] = zero16();
      const u16* Y; int ldy, Kb, koff;
      if (br == 0) { Y = (const u16*)((char*)p.out + OUT_OFF_YSB); ldy = 512; Kb = 512; koff = 0; }
      else if (br == 1) { Y = (const u16*)((char*)p.out + OUT_OFF_YDM); ldy = 256; Kb = 256; koff = 512; }
      else { Y = (const u16*)(ws + OFF_YM); ldy = 512; Kb = 512; koff = 768; }
      gemm_mainloop(acc, LdPlain{Y + (size_t)tm * 256 * ldy, ldy},
                    LdPlain{(const u16*)(ws + OFF_WOT) + (size_t)(tn * 128) * 1280 + koff, 1280}, Kb, smem, tid);
      char* tpark = uniform_ptr(ws + OFF_TPARK + (size_t)bid * (NTHR * 16 * 16));
#define P3_COMBINE(LOADP, STOREP) \
      _Pragma("unroll") for (int mi = 0; mi < 2; ++mi) \
      _Pragma("unroll") for (int ni = 0; ni < 2; ++ni) \
      _Pragma("unroll") for (int q4 = 0; q4 < 2; ++q4) { \
            uint4 gv = *reinterpret_cast<const uint4*>(gscr + ((mi * 2 + ni) * 2 + q4) * (NTHR * 16) + toff); \
            const uint32_t gw[4] = {gv.x, gv.y, gv.z, gv.w}; \
            _Pragma("unroll") for (int hf = 0; hf < 2; ++hf) { \
              float4 v; \
              v.x = bf_lo(gw[2 * hf]) * acc[mi][ni][8 * q4 + 4 * hf]; v.y = bf_hi(gw[2 * hf]) * acc[mi][ni][8 * q4 + 4 * hf + 1]; \
              v.z = bf_lo(gw[2 * hf + 1]) * acc[mi][ni][8 * q4 + 4 * hf + 2]; v.w = bf_hi(gw[2 * hf + 1]) * acc[mi][ni][8 * q4 + 4 * hf + 3]; \
              if (LOADP) { float4 t4 = *reinterpret_cast<const float4*>(tpark + (((mi * 2 + ni) * 2 + q4) * 2 + hf) * (NTHR * 16) + toff); v.x += t4.x; v.y += t4.y; v.z += t4.z; v.w += t4.w; } \
              if (STOREP) *reinterpret_cast<float4*>(tpark + (((mi * 2 + ni) * 2 + q4) * 2 + hf) * (NTHR * 16) + toff) = v; \
              acc[mi][ni][8 * q4 + 4 * hf] = v.x; acc[mi][ni][8 * q4 + 4 * hf + 1] = v.y; acc[mi][ni][8 * q4 + 4 * hf + 2] = v.z; acc[mi][ni][8 * q4 + 4 * hf + 3] = v.w; \
            } \
            __builtin_amdgcn_sched_barrier(0); \
      }
      if (br == 0) { P3_COMBINE(false, true) }
      else if (br == 1) { P3_COMBINE(true, true) }
      else { P3_COMBINE(true, false) }
      if (br == 2) stage_acc(acc, Cs, tid);
    }
    __syncthreads();
    {
      const int c8 = (tid & 15) * 8;
      u16* M = (u16*)(ws + OFF_MERGED);
#pragma unroll 2
      for (int pass = 0; pass < 8; ++pass) {
        int row = (tid >> 4) + 32 * pass;
        float v[8];
        float4 v0 = *reinterpret_cast<const float4*>(Cs + row * CLD + c8);
        float4 v1 = *reinterpret_cast<const float4*>(Cs + row * CLD + c8 + 4);
        v[0] = v0.x; v[1] = v0.y; v[2] = v0.z; v[3] = v0.w; v[4] = v1.x; v[5] = v1.y; v[6] = v1.z; v[7] = v1.w;
        *reinterpret_cast<uint4*>(M + (size_t)(tm * 256 + row) * 1024 + tn * 128 + c8) = pack8(v);
      }
    }
    __syncthreads();
  }
}

__device__ void phase4(const Params& p, int bid, int nb, char* smem) {
  char* ws = p.ws;
  float* Cs = reinterpret_cast<float*>(smem);
  const int xcd = bid & 7, lb = bid >> 3, nlb = (nb + 7 - xcd) >> 3;
  for (int li = lb; li < 32; li += nlb) {
    const int tid = launder(threadIdx.x);
    const int tm = 8 * xcd + (li >> 2), tn = li & 3;
    f32x4a acc[8][4];
    zero_acc16(acc);
    gemm_mainloop8x(acc, LdPlain{(const u16*)(ws + OFF_MERGED) + (size_t)tm * 256 * 1024, 1024},
                  LdPlain{(const u16*)(ws + OFF_WOUTT) + (size_t)(tn * 256) * 1024, 1024}, 1024, smem, tid);
#pragma unroll 1
    for (int bj = 0; bj < 2; ++bj) {
      stage_half16(acc, Cs, tid, bj);
      __syncthreads();
      const int c8 = (tid & 15) * 8, tn8 = tn * 2 + bj;
      u16* XG = (u16*)(ws + OFF_XG);
      float* rowss = (float*)(ws + OFF_ROWSS);
      const float4 g0 = *reinterpret_cast<const float4*>(p.g_ffn + tn8 * 128 + c8);
      const float4 g1 = *reinterpret_cast<const float4*>(p.g_ffn + tn8 * 128 + c8 + 4);
#pragma unroll 2
      for (int pass = 0; pass < 8; ++pass) {
        int row = (tid >> 4) + 32 * pass;
        size_t off = (size_t)(tm * 256 + row) * 1024 + tn8 * 128 + c8;
        float4 v0 = *reinterpret_cast<const float4*>(Cs + row * CLD + c8);
        float4 v1 = *reinterpret_cast<const float4*>(Cs + row * CLD + c8 + 4);
        float4 x0 = *reinterpret_cast<const float4*>(p.x + off);
        float4 x1 = *reinterpret_cast<const float4*>(p.x + off + 4);
        v0.x += x0.x; v0.y += x0.y; v0.z += x0.z; v0.w += x0.w;
        v1.x += x1.x; v1.y += x1.y; v1.z += x1.z; v1.w += x1.w;
        *reinterpret_cast<float4*>(p.out + off) = v0;
        *reinterpret_cast<float4*>(p.out + off + 4) = v1;
        float ss = v0.x * v0.x + v0.y * v0.y + v0.z * v0.z + v0.w * v0.w + v1.x * v1.x + v1.y * v1.y + v1.z * v1.z + v1.w * v1.w;
        ss += __shfl_xor(ss, 1); ss += __shfl_xor(ss, 2); ss += __shfl_xor(ss, 4); ss += __shfl_xor(ss, 8);
        if ((tid & 15) == 0) rowss[(size_t)(tm * 256 + row) * 8 + tn8] = ss;
        uint4 o; o.x = pack2(v0.x * g0.x, v0.y * g0.y); o.y = pack2(v0.z * g0.z, v0.w * g0.w);
        o.z = pack2(v1.x * g1.x, v1.y * g1.y); o.w = pack2(v1.z * g1.z, v1.w * g1.w);
        *reinterpret_cast<uint4*>(XG + off) = o;
      }
      __syncthreads();
    }
  }
}

#define DPP_MAX(v, ctrl) { uint32_t _t = (uint32_t)__builtin_amdgcn_update_dpp((int)(v), (int)(v), ctrl, 0xf, 0xf, false); v = (_t > v) ? _t : v; }
#define DPP_ADDF(v, ctrl) { float _t = __builtin_bit_cast(float, __builtin_amdgcn_update_dpp(__builtin_bit_cast(int, v), __builtin_bit_cast(int, v), ctrl, 0xf, 0xf, false)); v += _t; }

__device__ void phase6(const Params& p, int bid, int nb, char* smem) {
  char* ws = p.ws;
  float* Cs = reinterpret_cast<float*>(smem);
  const u16* h2 = (const u16*)(ws + OFF_XG);
  const float* rowss = (const float*)(ws + OFF_ROWSS);
  float* rstd_s = reinterpret_cast<float*>(smem + 98304);
  float* TS = (float*)(ws + OFF_TOPS);
  int* TI = (int*)(ws + OFF_TOPI);
  const int xcd = bid & 7, lb = bid >> 3, nlb = (nb + 7 - xcd) >> 3;
  for (int li = lb; li < 128; li += nlb) {
    const int tid = launder(threadIdx.x), lane = tid & 63, w = tid >> 6, wm = w >> 1, wn = w & 1, n = lane & 31, h = lane >> 5;
    int tm = 8 * xcd + (li >> 4), ct = li & 15;
    f32x16 acc[2][2];
#pragma unroll
    for (int a = 0; a < 2; ++a)
#pragma unroll
      for (int b = 0; b < 2; ++b) acc[a][b] = zero16();
    gemm_mainloop(acc, LdPlain{h2 + (size_t)tm * 256 * 1024, 1024},
                  LdPlain{(const u16*)(ws + OFF_WPQT) + (size_t)(ct * 128) * 1024, 1024}, 1024, smem, tid);
    if (tid < 256) {
      const float4 a = *reinterpret_cast<const float4*>(rowss + (size_t)(tm * 256 + tid) * 8);
      const float4 b = *reinterpret_cast<const float4*>(rowss + (size_t)(tm * 256 + tid) * 8 + 4);
      rstd_s[tid] = rsqrtf((a.x + a.y + a.z + a.w + b.x + b.y + b.z + b.w) * (1.f / 1024.f) + 1e-6f);
    }
    __syncthreads();
    {
      const u16* sk = (const u16*)(ws + OFF_SUBK) + (size_t)ct * 128 * 128;
      uint4 rb[4];
#pragma unroll
      for (int i = 0; i < 4; ++i) {
        int idx = tid + 512 * i, row = idx >> 4, c16 = idx & 15;
        rb[i] = *reinterpret_cast<const uint4*>(sk + row * 128 + c16 * 8);
      }
#pragma unroll
      for (int mi = 0; mi < 2; ++mi)
#pragma unroll
        for (int ni = 0; ni < 2; ++ni)
#pragma unroll
          for (int r = 0; r < 16; ++r) {
            int row = wm * 64 + mi * 32 + (r & 3) + 8 * (r >> 2) + 4 * h;
            int col = wn * 64 + ni * 32 + n;
            int panel = col >> 6, cc = col & 63;
            u16 bv = (u16)(pack2(acc[mi][ni][r] * rstd_s[row], 0.f) & 0xffffu);
            *reinterpret_cast<u16*>(smem + panel * 32768 + swz(row, cc >> 3) + (cc & 7) * 2) = bv;
          }
#pragma unroll
      for (int i = 0; i < 4; ++i) {
        int idx = tid + 512 * i, row = idx >> 4, c16 = idx & 15;
        *reinterpret_cast<uint4*>(smem + 65536 + (c16 >> 3) * 16384 + swz(row, c16 & 7)) = rb[i];
      }
    }
    __syncthreads();
#pragma unroll
    for (int a = 0; a < 2; ++a)
#pragma unroll
      for (int b = 0; b < 2; ++b) acc[a][b] = zero16();
#pragma unroll
    for (int pn = 0; pn < 2; ++pn)
#pragma unroll
      for (int ks = 0; ks < 4; ++ks) {
        bf16x8 af[2], bfr[2];
#pragma unroll
        for (int mi = 0; mi < 2; ++mi) af[mi] = *reinterpret_cast<const bf16x8*>(smem + pn * 32768 + swz(wm * 64 + mi * 32 + n, ks * 2 + h));
#pragma unroll
        for (int ni = 0; ni < 2; ++ni) bfr[ni] = *reinterpret_cast<const bf16x8*>(smem + 65536 + pn * 16384 + swz(wn * 64 + ni * 32 + n, ks * 2 + h));
#pragma unroll
        for (int mi = 0; mi < 2; ++mi)
#pragma unroll
          for (int ni = 0; ni < 2; ++ni) acc[mi][ni] = mfma32(af[mi], bfr[ni], acc[mi][ni]);
      }
    __syncthreads();
    stage_acc(acc, Cs, tid);
    __syncthreads();
    {
      const int q = lane >> 4, li = lane & 15;
#pragma unroll 1
      for (int grp = 0; grp < 8; grp += 2) {
        const int rowA = w * 32 + grp * 4 + q, rowB = rowA + 4;
        const float* rpA = Cs + rowA * CLD;
        const float* rpB = Cs + rowB * CLD;
        uint32_t kA[8], kB[8];
        {
          float4 v0 = *reinterpret_cast<const float4*>(rpA + li * 8), v1 = *reinterpret_cast<const float4*>(rpA + li * 8 + 4);
          float4 w0 = *reinterpret_cast<const float4*>(rpB + li * 8), w1 = *reinterpret_cast<const float4*>(rpB + li * 8 + 4);
          float va[8] = {v0.x, v0.y, v0.z, v0.w, v1.x, v1.y, v1.z, v1.w};
          float vb[8] = {w0.x, w0.y, w0.z, w0.w, w1.x, w1.y, w1.z, w1.w};
#pragma unroll
          for (int e = 0; e < 8; ++e) {
            uint32_t u = __float_as_uint(va[e]);
            u = (u & 0x80000000u) ? ~u : (u | 0x80000000u);
            kA[e] = (u & ~127u) | (uint32_t)(127 - (li * 8 + e));
            u = __float_as_uint(vb[e]);
            u = (u & 0x80000000u) ? ~u : (u | 0x80000000u);
            kB[e] = (u & ~127u) | (uint32_t)(127 - (li * 8 + e));
          }
        }
#pragma unroll
        for (int ph = 0; ph < 8; ++ph) {
#pragma unroll
          for (int e = (ph & 1); e + 1 < 8; e += 2) {
            uint32_t hi = kA[e] > kA[e + 1] ? kA[e] : kA[e + 1], lo = kA[e] > kA[e + 1] ? kA[e + 1] : kA[e];
            kA[e] = hi; kA[e + 1] = lo;
            hi = kB[e] > kB[e + 1] ? kB[e] : kB[e + 1]; lo = kB[e] > kB[e + 1] ? kB[e + 1] : kB[e];
            kB[e] = hi; kB[e + 1] = lo;
          }
        }
        uint32_t resA = 0, resB = 0;
#pragma unroll 4
        for (int itx = 0; itx < 16; ++itx) {
          uint32_t mA = kA[0], mB = kB[0];
          DPP_MAX(mA, 0xB1); DPP_MAX(mB, 0xB1);
          DPP_MAX(mA, 0x4E); DPP_MAX(mB, 0x4E);
          DPP_MAX(mA, 0x141); DPP_MAX(mB, 0x141);
          DPP_MAX(mA, 0x140); DPP_MAX(mB, 0x140);
          const bool wA = (kA[0] == mA), wB = (kB[0] == mB);
#pragma unroll
          for (int e = 0; e < 7; ++e) { kA[e] = wA ? kA[e + 1] : kA[e]; kB[e] = wB ? kB[e + 1] : kB[e]; }
          kA[7] = wA ? 0u : kA[7]; kB[7] = wB ? 0u : kB[7];
          resA = (li == itx) ? mA : resA; resB = (li == itx) ? mB : resB;
        }
        const int colA = 127 - (int)(resA & 127u), colB = 127 - (int)(resB & 127u);
        const float valA = rpA[colA], valB = rpB[colB];
        const size_t oA = ((size_t)(tm * 256 + rowA) * 16 + ct) * 16 + li, oB = ((size_t)(tm * 256 + rowB) * 16 + ct) * 16 + li;
        TS[oA] = valA; TI[oA] = colA; TS[oB] = valB; TI[oB] = colB;
      }
    }
    __syncthreads();
  }
}

DI f32x2 cvt8(unsigned w, bool hi) { return hi ? __builtin_amdgcn_cvt_pk_f32_fp8((int)w, true) : __builtin_amdgcn_cvt_pk_f32_fp8((int)w, false); }
constexpr size_t OFF_LIDX = OFF_QKV;
constexpr size_t OFF_GATE = OFF_QKV + 8 * MB;
constexpr size_t OFF_DOTS = OFF_QKV + 16 * MB;
#define DPP_F(v, ctrl) __builtin_bit_cast(float, __builtin_amdgcn_update_dpp(0, __builtin_bit_cast(int, (v)), ctrl, 0xf, 0xf, false))

__device__ void phase7a(const Params& p, int bid, int nb, char* smem) {
  char* ws = p.ws;
  const int lane = threadIdx.x & 63, w = __builtin_amdgcn_readfirstlane(threadIdx.x >> 6);
  int* lidx = reinterpret_cast<int*>(smem) + w * 896;
  float* lw = reinterpret_cast<float*>(smem) + w * 896 + 128;
  float* lts = reinterpret_cast<float*>(smem) + w * 896 + 384;
  int* lti = reinterpret_cast<int*>(smem) + w * 896 + 640;
  const float* TS = (const float*)(ws + OFF_TOPS);
  const int* TI = (const int*)(ws + OFF_TOPI);
  int* LIDX = (int*)(ws + OFF_LIDX);
  float* GATE = (float*)(ws + OFF_GATE);
  int ca, cb;
  if (lane < 16) { ca = 0; cb = lane; } else if (lane < 24) { ca = 1; cb = lane - 16; } else if (lane < 29) { ca = 2; cb = lane - 24; }
  else if (lane < 33) { ca = 3; cb = lane - 29; } else if (lane < 36) { ca = 4; cb = lane - 33; } else if (lane < 38) { ca = 5; cb = lane - 36; }
  else if (lane < 40) { ca = 6; cb = lane - 38; } else if (lane < 42) { ca = 7; cb = lane - 40; } else if (lane < 50) { ca = lane - 34; cb = 0; }
  else { ca = 0; cb = 0; }
  const bool isc = lane < 50;
  const int tstride = nb * WPB;
  int t = bid * WPB + w;
  float4 pts; int4 pti;
  if (t < T_) { pts = *reinterpret_cast<const float4*>(TS + (size_t)t * 256 + lane * 4); pti = *reinterpret_cast<const int4*>(TI + (size_t)t * 256 + lane * 4); }
  for (; t < T_; t += tstride) {
    *reinterpret_cast<float4*>(lts + lane * 4) = pts;
    *reinterpret_cast<int4*>(lti + lane * 4) = pti;
    if (t + tstride < T_) { pts = *reinterpret_cast<const float4*>(TS + (size_t)(t + tstride) * 256 + lane * 4); pti = *reinterpret_cast<const int4*>(TI + (size_t)(t + tstride) * 256 + lane * 4); }
    __builtin_amdgcn_fence(__ATOMIC_RELEASE, "wavefront");
    __builtin_amdgcn_wave_barrier();
#pragma unroll 2
    for (int hh = 0; hh < 8; ++hh) {
      const float key = lts[hh * 32 + ca] + lts[hh * 32 + 16 + cb];
      const int eidx = lti[hh * 32 + ca] * 128 + lti[hh * 32 + 16 + cb];
      uint32_t uk = __float_as_uint(key);
      uk = (uk & 0x80000000u) ? ~uk : (uk | 0x80000000u);
      uk = isc ? ((uk & ~63u) | (uint32_t)(63 - lane)) : 0u;
      int rank = 0;
#pragma unroll
      for (int j = 0; j < 50; ++j) {
        const uint32_t kj = (uint32_t)__builtin_amdgcn_readlane((int)uk, j);
        rank += (kj > uk) ? 1 : 0;
      }
      const bool sel = isc && rank < 16;
      const float mx = __builtin_bit_cast(float, __builtin_amdgcn_readlane(__builtin_bit_cast(int, key), 0));
      if (sel) { lidx[hh * 16 + rank] = eidx; lw[hh * 16 + rank] = __expf(key - mx); }
    }
    __builtin_amdgcn_fence(__ATOMIC_RELEASE, "wavefront");
    __builtin_amdgcn_wave_barrier();
    LIDX[(size_t)t * 128 + lane] = lidx[lane]; LIDX[(size_t)t * 128 + 64 + lane] = lidx[lane + 64];
    GATE[(size_t)t * 128 + lane] = lw[lane]; GATE[(size_t)t * 128 + 64 + lane] = lw[lane + 64];
    __builtin_amdgcn_fence(__ATOMIC_RELEASE, "wavefront");
    __builtin_amdgcn_wave_barrier();
  }
}

constexpr size_t OFF_PD = OFF_QKV + 16 * MB;
constexpr size_t OFF_WFIN = OFF_QKV + 80 * MB;
__device__ void phase7b(const Params& p, int bid, int nb, char* smem) {
  char* ws = p.ws;
  const int lane = threadIdx.x & 63, w = __builtin_amdgcn_readfirstlane(threadIdx.x >> 6);
  int* lidx0 = reinterpret_cast<int*>(smem) + w * 256;
  int* lidx1 = lidx0 + 128;
  const u16* XG = (const u16*)(ws + OFF_XG);
  const int* LIDX = (const int*)(ws + OFF_LIDX);
  const int xs = bid & 7;
  const unsigned char* U8 = (const unsigned char*)(ws + OFF_U8) + (size_t)xs * (16384 * 128);
  float* PD = (float*)(ws + OFF_PD) + (size_t)xs * T_ * 128;
  const int lwv = (bid >> 3) * WPB + w, nwv = ((nb + 7 - xs) >> 3) * WPB;
  const int j = lane >> 3, c = lane & 7;
  const bool c2 = (c & 4) != 0, c1 = (c & 2) != 0, c0 = (c & 1) != 0;
  const int itb = (c2 ? 8 : 0) + (c1 ? 4 : 0) + (c0 ? 2 : 0);
  const uint32_t coff = (uint32_t)(xs * 128 + c * 16);
  int pe0 = 0, pe1 = 0; uint4 pxa = make_uint4(0, 0, 0, 0), pxb = make_uint4(0, 0, 0, 0);
#define P7B_PREFETCH(tt) { pe0 = LIDX[(size_t)(tt) * 128 + lane]; pe1 = LIDX[(size_t)(tt) * 128 + 64 + lane]; \
    pxa = *reinterpret_cast<const uint4*>(XG + (size_t)(tt) * 1024 + coff); pxb = *reinterpret_cast<const uint4*>(XG + (size_t)(tt) * 1024 + coff + 8); }
#define P7B_STAGE(LB, BUF, HX, tt) { \
    LB[lane] = pe0; LB[lane + 64] = pe1; \
    HX[0] = f32x2{bf_lo(pxa.x), bf_hi(pxa.x)}; HX[1] = f32x2{bf_lo(pxa.y), bf_hi(pxa.y)}; HX[2] = f32x2{bf_lo(pxa.z), bf_hi(pxa.z)}; HX[3] = f32x2{bf_lo(pxa.w), bf_hi(pxa.w)}; \
    HX[4] = f32x2{bf_lo(pxb.x), bf_hi(pxb.x)}; HX[5] = f32x2{bf_lo(pxb.y), bf_hi(pxb.y)}; HX[6] = f32x2{bf_lo(pxb.z), bf_hi(pxb.z)}; HX[7] = f32x2{bf_lo(pxb.w), bf_hi(pxb.w)}; \
    if ((tt) + nwv < T_) P7B_PREFETCH((tt) + nwv) \
    __builtin_amdgcn_fence(__ATOMIC_RELEASE, "wavefront"); __builtin_amdgcn_wave_barrier(); \
    _Pragma("unroll") for (int it = 0; it < 16; ++it) { const int e_ = LB[it * 8 + j]; BUF[it] = *reinterpret_cast<const uint4*>(U8 + (uint32_t)(e_ * 128 + c * 16)); } }
#define P7B_COMP(BUF, HX, tt) { \
    float d_[16]; \
    _Pragma("unroll") for (int it = 0; it < 16; ++it) { \
      f32x2 d2 = cvt8(BUF[it].x, false) * HX[0]; \
      d2 += cvt8(BUF[it].x, true) * HX[1]; d2 += cvt8(BUF[it].y, false) * HX[2]; d2 += cvt8(BUF[it].y, true) * HX[3]; \
      d2 += cvt8(BUF[it].z, false) * HX[4]; d2 += cvt8(BUF[it].z, true) * HX[5]; d2 += cvt8(BUF[it].w, false) * HX[6]; d2 += cvt8(BUF[it].w, true) * HX[7]; \
      d_[it] = d2.x + d2.y; } \
    float e_[8]; \
    _Pragma("unroll") for (int i = 0; i < 8; ++i) { float mine = c2 ? d_[i + 8] : d_[i], snd = c2 ? d_[i] : d_[i + 8]; e_[i] = mine + DPP_F(snd, 0x141); } \
    float f_[4]; \
    _Pragma("unroll") for (int i = 0; i < 4; ++i) { float mine = c1 ? e_[i + 4] : e_[i], snd = c1 ? e_[i] : e_[i + 4]; f_[i] = mine + DPP_F(snd, 0x4E); } \
    float g_[2]; \
    _Pragma("unroll") for (int i = 0; i < 2; ++i) { float mine = c0 ? f_[i + 2] : f_[i], snd = c0 ? f_[i] : f_[i + 2]; g_[i] = mine + DPP_F(snd, 0xB1); } \
    PD[(size_t)(tt) * 128 + itb * 8 + j] = g_[0]; PD[(size_t)(tt) * 128 + (itb + 1) * 8 + j] = g_[1]; }
  int t = lwv;
  uint4 bA[16], bB[16];
  f32x2 hA[8], hB[8];
  if (t < T_) { P7B_PREFETCH(t) P7B_STAGE(lidx0, bA, hA, t) }
  for (; t < T_; t += 2 * nwv) {
    const int t1 = t + nwv, t2 = t + 2 * nwv;
    if (t1 < T_) P7B_STAGE(lidx1, bB, hB, t1)
    P7B_COMP(bA, hA, t)
    if (t1 < T_) {
      if (t2 < T_) P7B_STAGE(lidx0, bA, hA, t2)
      P7B_COMP(bB, hB, t1)
    }
  }
}

__device__ void phase7b2(const Params& p, int bid, int nb) {
  char* ws = p.ws;
  const int lane = threadIdx.x & 63, w = __builtin_amdgcn_readfirstlane(threadIdx.x >> 6);
  const float* USC = (const float*)(ws + OFF_USC);
  const float* rowss = (const float*)(ws + OFF_ROWSS);
  const int* LIDX = (const int*)(ws + OFF_LIDX);
  const float* GATE = (const float*)(ws + OFF_GATE);
  const float* PD = (const float*)(ws + OFF_PD);
  float* WF = (float*)(ws + OFF_WFIN);
  for (int t = bid * WPB + w; t < T_; t += nb * WPB) {
    const int e0 = LIDX[(size_t)t * 128 + lane], e1 = LIDX[(size_t)t * 128 + 64 + lane];
    const float g0 = GATE[(size_t)t * 128 + lane], g1 = GATE[(size_t)t * 128 + 64 + lane];
    float d0 = 0.f, d1 = 0.f;
#pragma unroll
    for (int x = 0; x < 8; ++x) { d0 += PD[((size_t)x * T_ + t) * 128 + lane]; d1 += PD[((size_t)x * T_ + t) * 128 + 64 + lane]; }
    const float pss = (lane < 8) ? rowss[(size_t)t * 8 + lane] : 0.f;
    const float rstd = rsqrtf(wave_sum(pss) * (1.f / 1024.f) + 1e-6f);
    const float2 sc0 = *reinterpret_cast<const float2*>(USC + (size_t)e0 * 2);
    const float2 sc1 = *reinterpret_cast<const float2*>(USC + (size_t)e1 * 2);
    const float da = d0 * rstd * sc0.x, db = d1 * rstd * sc1.x;
    const float acta = 0.5f * da * (1.f + erff(da * 0.70710678118654752f));
    const float actb = 0.5f * db * (1.f + erff(db * 0.70710678118654752f));
    float sa = g0, sb = g1;
    DPP_ADDF(sa, 0xB1); DPP_ADDF(sa, 0x4E); DPP_ADDF(sa, 0x141); DPP_ADDF(sa, 0x140);
    DPP_ADDF(sb, 0xB1); DPP_ADDF(sb, 0x4E); DPP_ADDF(sb, 0x141); DPP_ADDF(sb, 0x140);
    WF[(size_t)t * 128 + lane] = (g0 / sa) * acta * sc0.y;
    WF[(size_t)t * 128 + 64 + lane] = (g1 / sb) * actb * sc1.y;
  }
}

__device__ void phase7c(const Params& p, int bid, int nb, char* smem, float* dstbase) {
  char* ws = p.ws;
  const int lane = threadIdx.x & 63, w = __builtin_amdgcn_readfirstlane(threadIdx.x >> 6);
  int* lidx0 = reinterpret_cast<int*>(smem) + w * 1536;
  int* lidx1 = lidx0 + 128;
  float* lw0 = reinterpret_cast<float*>(smem) + w * 1536 + 256;
  float* lw1 = lw0 + 128;
  float* red = reinterpret_cast<float*>(smem) + w * 1536 + 512;
  const int* LIDX = (const int*)(ws + OFF_LIDX);
  const float* WF = (const float*)(ws + OFF_WFIN);
  const int xs = bid & 7;
  const unsigned char* V8 = (const unsigned char*)(ws + OFF_V8) + (size_t)xs * (16384 * 128);
  const int lwv = (bid >> 3) * WPB + w, nwv = ((nb + 7 - xs) >> 3) * WPB;
  const int j = lane >> 3, c = lane & 7;
  const uint32_t coff = (uint32_t)(xs * 128 + c * 16);
  int pe0 = 0, pe1 = 0; float pw0 = 0.f, pw1 = 0.f;
#define P7C_PREFETCH(tt) { pe0 = LIDX[(size_t)(tt) * 128 + lane]; pe1 = LIDX[(size_t)(tt) * 128 + 64 + lane]; \
    pw0 = WF[(size_t)(tt) * 128 + lane]; pw1 = WF[(size_t)(tt) * 128 + 64 + lane]; }
#define P7C_STAGE(LB, LWB, BUF, tt) { \
    LB[lane] = pe0; LB[lane + 64] = pe1; LWB[lane] = pw0; LWB[lane + 64] = pw1; \
    if ((tt) + nwv < T_) P7C_PREFETCH((tt) + nwv) \
    __builtin_amdgcn_fence(__ATOMIC_RELEASE, "wavefront"); __builtin_amdgcn_wave_barrier(); \
    _Pragma("unroll") for (int it = 0; it < 16; ++it) { const int e_ = LB[it * 8 + j]; BUF[it] = *reinterpret_cast<const uint4*>(V8 + (uint32_t)(e_ * 128 + c * 16)); } }
#define P7C_COMP(LWB, BUF, tt) { \
    f32x2 acc[8]; \
    _Pragma("unroll") for (int q = 0; q < 8; ++q) acc[q] = f32x2{0.f, 0.f}; \
    _Pragma("unroll") for (int it = 0; it < 16; ++it) { \
      const float wk_ = LWB[it * 8 + j]; const f32x2 w2 = f32x2{wk_, wk_}; \
      acc[0] += w2 * cvt8(BUF[it].x, false); acc[1] += w2 * cvt8(BUF[it].x, true); \
      acc[2] += w2 * cvt8(BUF[it].y, false); acc[3] += w2 * cvt8(BUF[it].y, true); \
      acc[4] += w2 * cvt8(BUF[it].z, false); acc[5] += w2 * cvt8(BUF[it].z, true); \
      acc[6] += w2 * cvt8(BUF[it].w, false); acc[7] += w2 * cvt8(BUF[it].w, true); } \
    _Pragma("unroll") for (int q = 0; q < 4; ++q) \
      *reinterpret_cast<float4*>(red + j * 128 + c * 16 + q * 4) = make_float4(acc[2 * q].x, acc[2 * q].y, acc[2 * q + 1].x, acc[2 * q + 1].y); \
    __builtin_amdgcn_fence(__ATOMIC_RELEASE, "wavefront"); __builtin_amdgcn_wave_barrier(); \
    float2 sum = *reinterpret_cast<const float2*>(red + 2 * lane); \
    _Pragma("unroll") for (int jj = 1; jj < 8; ++jj) { float2 v = *reinterpret_cast<const float2*>(red + jj * 128 + 2 * lane); sum.x += v.x; sum.y += v.y; } \
    const size_t o = (size_t)(tt) * 1024 + xs * 128 + 2 * lane; \
    float2 x0 = *reinterpret_cast<const float2*>(p.out + o); \
    x0.x += sum.x; x0.y += sum.y; \
    *reinterpret_cast<float2*>(dstbase + o) = x0; \
    __builtin_amdgcn_fence(__ATOMIC_RELEASE, "wavefront"); __builtin_amdgcn_wave_barrier(); }
  int t = lwv;
  uint4 bA[16], bB[16];
  if (t < T_) { P7C_PREFETCH(t) P7C_STAGE(lidx0, lw0, bA, t) }
  for (; t < T_; t += 2 * nwv) {
    const int t1 = t + nwv, t2 = t + 2 * nwv;
    if (t1 < T_) P7C_STAGE(lidx1, lw1, bB, t1)
    P7C_COMP(lw0, bA, t)
    if (t1 < T_) {
      if (t2 < T_) P7C_STAGE(lidx0, lw0, bA, t2)
      P7C_COMP(lw1, bB, t1)
    }
  }
}

#define XB_TMO      128
#define XB_XCNT(j)  (256  + 64 * (j))
#define XB_XSUB(j)  (1280 + 64 * (j))
#define XB_XGEN(j)  (2304 + 64 * (j))
#define XB_TOP      3328
#define XB_TOPGEN   3392
#define XCD_BAR_WORDS 3456
#define XB_SPIN_CAP (1u << 20)
#define LAS __attribute__((address_space(3)))
DI unsigned xb_ld(unsigned* p)              { return __hip_atomic_load(p, __ATOMIC_RELAXED, __HIP_MEMORY_SCOPE_AGENT); }
DI unsigned xb_add(unsigned* p, unsigned v) { return __hip_atomic_fetch_add(p, v, __ATOMIC_RELAXED, __HIP_MEMORY_SCOPE_AGENT); }
DI unsigned xb_xcc_id() { return (unsigned)__builtin_amdgcn_s_getreg((3 << 11) | 20) & 0xFu; }
#define XB_SPIN(cond, bar) do { unsigned _sp = 0; while (cond) { __builtin_amdgcn_s_sleep(1); \
    if ((++_sp & 255u) == 0u) { if (xb_ld(&(bar)[XB_TMO])) break; if (_sp > XB_SPIN_CAP) { atomicAdd(&(bar)[XB_TMO], 1u); break; } } } } while (0)
struct XcdBarrier { unsigned* bar; unsigned x; volatile LAS unsigned* st; };
DI XcdBarrier xcd_barrier_post(unsigned* bar, volatile LAS unsigned* st) {
  XcdBarrier b; b.bar = bar; b.x = xb_xcc_id(); b.st = st;
  if (threadIdx.x == 0) (void)xb_add(&bar[XB_XCNT(b.x)], 1u);
  return b;
}
DI void xcd_barrier_complete(unsigned* bar, unsigned x, unsigned& nloc, unsigned& nx) {
  const unsigned G = gridDim.x * gridDim.y * gridDim.z;
  unsigned sum, cnt, mine, sp = 0u;
  for (;;) {
    sum = 0u; cnt = 0u; mine = 0u;
#pragma unroll
    for (unsigned j = 0; j < 16; ++j) { const unsigned c = xb_ld(&bar[XB_XCNT(j)]); sum += c; cnt += (c > 0u) ? 1u : 0u; mine = (j == x) ? c : mine; }
    if (sum == G) break;
    __builtin_amdgcn_s_sleep(1);
    if ((++sp & 255u) == 0u) { if (xb_ld(&bar[XB_TMO])) break; if (sp > XB_SPIN_CAP) { atomicAdd(&bar[XB_TMO], 1u); break; } }
  }
  nloc = mine > 0u ? mine : 1u; nx = cnt > 0u ? cnt : 1u;
}
DI void xcd_barrier(const XcdBarrier& b) {
  asm volatile("s_waitcnt vmcnt(0)" ::: "memory");
  __syncthreads();
  if (threadIdx.x == 0) {
    unsigned* bar = b.bar;
    __builtin_amdgcn_s_waitcnt(0);
    unsigned nloc = b.st[0], nx = b.st[1];
    if (nloc == 0u) { xcd_barrier_complete(bar, b.x, nloc, nx); b.st[0] = nloc; b.st[1] = nx; }
    const unsigned old = xb_add(&bar[XB_XSUB(b.x)], 1u);
    const unsigned gen = old / nloc;
    if (old + 1u == (gen + 1u) * nloc) {
      __builtin_amdgcn_fence(__ATOMIC_RELEASE, "agent");
      asm volatile("s_waitcnt vmcnt(0)" ::: "memory");
      const unsigned og = xb_add(&bar[XB_TOP], 1u);
      const unsigned tg = og / nx;
      if (og + 1u == (tg + 1u) * nx) xb_add(&bar[XB_TOPGEN], 1u);
      else XB_SPIN(xb_ld(&bar[XB_TOPGEN]) == tg, bar);
      __builtin_amdgcn_fence(__ATOMIC_ACQUIRE, "agent");
      xb_add(&bar[XB_XGEN(b.x)], 1u);
      asm volatile("s_waitcnt vmcnt(0)" ::: "memory");
    } else {
      XB_SPIN(xb_ld(&bar[XB_XGEN(b.x)]) == gen, bar);
      __builtin_amdgcn_fence(__ATOMIC_ACQUIRE, "agent");
      asm volatile("s_waitcnt vmcnt(0)" ::: "memory");
    }
  }
  __syncthreads();
}

constexpr int SMEM_BYTES = 3 * STAGE_BYTES;

#if MK_FUSED
__global__ void __launch_bounds__(NTHR, 2) mega_kernel(Params p) {
  __shared__ __attribute__((aligned(16))) char smem[SMEM_BYTES];
  cg::grid_group grid = cg::this_grid();
  __shared__ uint4 xb_words;
  if (threadIdx.x == 0) xb_words = make_uint4(0u, 0u, 0u, 0u);
  __syncthreads();
  (void)xcd_barrier_post((unsigned*)(p.ws + OFF_BAR), (volatile LAS unsigned*)&xb_words);
  const int bid = blockIdx.x, nb = gridDim.x;
#define XBAR() { XcdBarrier xb_; xb_.bar = (unsigned*)(p.ws + OFF_BAR); xb_.x = xb_xcc_id(); xb_.st = (volatile LAS unsigned*)&xb_words; xcd_barrier(xb_); }
#define RUNP(ph, call) { int nrep_ = launder_s((PROBE_DUP & (1 << ph)) ? 2 : 1); _Pragma("unroll 1") for (int rep_ = 0; rep_ < nrep_; ++rep_) { call; XBAR() } }
  RUNP(0, phase0(p, bid, nb, smem))
  RUNP(1, phase1(p, bid, nb, smem))
  RUNP(2, phase2(p, bid, nb, smem))
  RUNP(3, phase2b(p, bid, nb))
  RUNP(4, phase3(p, bid, nb, smem))
  RUNP(5, phase4(p, bid, nb, smem))
  RUNP(7, phase6(p, bid, nb, smem))
  phase7a(p, bid, nb, smem); XBAR()
  phase7b(p, bid, nb, smem); XBAR()
  phase7b2(p, bid, nb); XBAR()
  phase7c(p, bid, nb, smem, p.out);
  if (p.ws == nullptr) grid.sync();
}
#else
#define PHASE_KERNEL(name, call) \
  __global__ void __launch_bounds__(NTHR, 2) name(Params p) { \
    __shared__ __attribute__((aligned(16))) char smem[SMEM_BYTES]; \
    const int bid = blockIdx.x, nb = gridDim.x; (void)smem; call; }
PHASE_KERNEL(k_p0, phase0(p, bid, nb, smem))
PHASE_KERNEL(k_p1, phase1(p, bid, nb, smem))
PHASE_KERNEL(k_p2, phase2(p, bid, nb, smem))
PHASE_KERNEL(k_p2b, phase2b(p, bid, nb))
PHASE_KERNEL(k_p3, phase3(p, bid, nb, smem))
PHASE_KERNEL(k_p4, phase4(p, bid, nb, smem))
PHASE_KERNEL(k_p6, phase6(p, bid, nb, smem))
PHASE_KERNEL(k_p7a, phase7a(p, bid, nb, smem))
PHASE_KERNEL(k_p7b, phase7b(p, bid, nb, smem))
PHASE_KERNEL(k_p7b2, phase7b2(p, bid, nb))
PHASE_KERNEL(k_p7c, phase7c(p, bid, nb, smem, p.out))
#endif

extern "C" void kernel_launch(void* const* d_in, const int* in_sizes, int n_in, void* d_out, int out_size, void* d_ws,
                              size_t ws_size, hipStream_t stream) {
  Params p{};
  p.x = (const float*)d_in[0]; p.mem = (const float*)d_in[1]; p.g_mix = (const float*)d_in[2]; p.g_mem = (const float*)d_in[3];
  p.w_in = (const float*)d_in[4]; p.w_mem_kv = (const float*)d_in[5]; p.g_q_dil = (const float*)d_in[6]; p.g_k_dil = (const float*)d_in[7];
  p.g_q_mem = (const float*)d_in[8]; p.g_k_mem = (const float*)d_in[9]; p.w_o_sb = (const float*)d_in[10]; p.w_o_dil = (const float*)d_in[11];
  p.w_o_mem = (const float*)d_in[12]; p.w_gate = (const float*)d_in[13]; p.b_gate = (const float*)d_in[14]; p.w_out = (const float*)d_in[15];
  p.g_ffn = (const float*)d_in[16]; p.w_peer_q = (const float*)d_in[17]; p.subkeys = (const float*)d_in[18]; p.peer_u = (const float*)d_in[19];
  p.peer_v = (const float*)d_in[20];
  p.out = (float*)d_out; p.ws = (char*)d_ws;
#if MK_FUSED
  static int grid_blocks = 0;
  if (!grid_blocks) {
    int dev = 0, cus = 0, per_cu = 0;
    hipGetDevice(&dev);
    hipDeviceGetAttribute(&cus, hipDeviceAttributeMultiprocessorCount, dev);
    hipOccupancyMaxActiveBlocksPerMultiprocessor(&per_cu, mega_kernel, NTHR, 0);
    per_cu = 1;
    grid_blocks = (cus * per_cu) & ~7;
  }
  hipMemsetAsync((char*)d_ws + OFF_BAR, 0, XCD_BAR_WORDS * sizeof(unsigned), stream);
  void* args[] = {&p};
  hipError_t e = hipLaunchCooperativeKernel((void*)mega_kernel, dim3(grid_blocks), dim3(NTHR), args, 0, stream);
  if (e != hipSuccess) fprintf(stderr, "cooperative launch failed: %s (grid %d)\n", hipGetErrorString(e), grid_blocks);
#else
  const int G = 512;
  k_p0<<<G, NTHR, 0, stream>>>(p);
  k_p1<<<G, NTHR, 0, stream>>>(p);
  k_p2<<<G, NTHR, 0, stream>>>(p);
  k_p2b<<<G, NTHR, 0, stream>>>(p);
  k_p3<<<G, NTHR, 0, stream>>>(p);
  k_p4<<<G, NTHR, 0, stream>>>(p);
  k_p6<<<G, NTHR, 0, stream>>>(p);
  k_p7a<<<G, NTHR, 0, stream>>>(p);
  k_p7b<<<G, NTHR, 0, stream>>>(p);
  k_p7b2<<<G, NTHR, 0, stream>>>(p);
  k_p7c<<<G, NTHR, 0, stream>>>(p);
#endif
}
```

```cpp
#include <hip/hip_runtime.h>
#include <hip/hip_cooperative_groups.h>
#include <stdint.h>
#include <cstdio>
namespace cg = cooperative_groups;

#ifndef PROBE_DUP
#define PROBE_DUP 0
#endif
#ifndef MK_FUSED
#define MK_FUSED 1
#endif

typedef unsigned short u16;
typedef __attribute__((ext_vector_type(8))) short bf16x8;
typedef __attribute__((ext_vector_type(16))) float f32x16;
typedef __attribute__((ext_vector_type(2))) float f32x2;
typedef __attribute__((ext_vector_type(2))) __bf16 bf16x2_t;

#define DI __device__ __forceinline__
#define NTHR 512
#define WPB 8

constexpr int T_ = 16384;
constexpr size_t MB = 1048576;
constexpr size_t OFF_WINT = 0;
constexpr size_t OFF_WGT  = OFF_WINT + 4352ull * 1024 * 2;
constexpr size_t OFF_WKVT = OFF_WGT + 3072ull * 1024 * 2;
constexpr size_t OFF_WOT  = OFF_WKVT + 1024ull * 1024 * 2;
constexpr size_t OFF_WOUTT = OFF_WOT + 1024ull * 1280 * 2;
constexpr size_t OFF_WPQT = OFF_WOUTT + 1024ull * 1024 * 2;
constexpr size_t OFF_SUBK = OFF_WPQT + 2048ull * 1024 * 2;
constexpr size_t OFF_QKV  = 26 * MB;
constexpr size_t OFF_QSB  = OFF_QKV;
constexpr size_t OFF_KSB  = OFF_QSB + 16 * MB;
constexpr size_t OFF_VTSB = OFF_KSB + 16 * MB;
constexpr size_t OFF_QD   = OFF_VTSB + 16 * MB;
constexpr size_t OFF_KD   = OFF_QD + 24 * MB;
constexpr size_t OFF_VTD  = OFF_KD + 24 * MB;
constexpr size_t OFF_QM   = OFF_VTD + 24 * MB;
constexpr size_t OFF_KM   = OFF_QM + 16 * MB;
constexpr size_t OFF_VTM  = OFF_KM + 2 * MB;
constexpr size_t OFF_YD   = OFF_QKV + 140 * MB;
constexpr size_t OFF_YM   = OFF_YD + 24 * MB;
constexpr size_t OFF_U8   = OFF_YM + 16 * MB;
constexpr size_t OFF_V8   = OFF_U8 + 16 * MB;
constexpr size_t OFF_USC  = OFF_V8 + 16 * MB;
constexpr size_t OFF_ROWSS = OFF_USC + 1 * MB;
constexpr size_t OFF_BAR  = OFF_ROWSS + 1 * MB;
constexpr size_t OFF_MERGED = OFF_QKV + 64 * MB;
constexpr size_t OFF_TOPS = OFF_QKV + 96 * MB;
constexpr size_t OFF_TOPI = OFF_QKV + 112 * MB;
constexpr size_t OFF_GSCR = OFF_QKV;
constexpr size_t OFF_TPARK = OFF_QKV + 16 * MB;
constexpr size_t OFF_XG   = OFF_YD;
constexpr size_t OUT_OFF_H = 0;
constexpr size_t OUT_OFF_MEMH = 32 * MB;
constexpr size_t OUT_OFF_YSB = 36 * MB;
constexpr size_t OUT_OFF_LSE = 52 * MB;
constexpr size_t OUT_OFF_YDM = 53 * MB;

struct Params {
  const float *x, *mem, *g_mix, *g_mem, *w_in, *w_mem_kv, *g_q_dil, *g_k_dil, *g_q_mem, *g_k_mem;
  const float *w_o_sb, *w_o_dil, *w_o_mem, *w_gate, *b_gate, *w_out, *g_ffn, *w_peer_q, *subkeys, *peer_u, *peer_v;
  float* out;
  char* ws;
};

DI uint32_t pack2(float a, float b) {
  f32x2 v = {a, b};
  bf16x2_t r = __builtin_convertvector(v, bf16x2_t);
  return __builtin_bit_cast(uint32_t, r);
}
DI uint4 pack8(const float* v) {
  uint4 r; r.x = pack2(v[0], v[1]); r.y = pack2(v[2], v[3]); r.z = pack2(v[4], v[5]); r.w = pack2(v[6], v[7]);
  return r;
}
DI float bf_lo(uint32_t u) { return __uint_as_float(u << 16); }
DI float bf_hi(uint32_t u) { return __uint_as_float(u & 0xffff0000u); }
DI float wave_sum(float v) {
#pragma unroll
  for (int o = 32; o; o >>= 1) v += __shfl_xor(v, o);
  return v;
}
DI f32x16 mfma32(bf16x8 a, bf16x8 b, f32x16 c) { return __builtin_amdgcn_mfma_f32_32x32x16_bf16(a, b, c, 0, 0, 0); }
DI bf16x8 ld16(const u16* p) { return *reinterpret_cast<const bf16x8*>(p); }
DI bf16x8 as_bf16x8(uint4 v) { return __builtin_bit_cast(bf16x8, v); }
DI f32x16 zero16() { f32x16 z; for (int i = 0; i < 16; ++i) z[i] = 0.f; return z; }
DI int launder(int v) { asm volatile("" : "+v"(v)); return v; }
DI char* uniform_ptr(char* p) {
  uint64_t v = (uint64_t)p;
  uint32_t lo = __builtin_amdgcn_readfirstlane((uint32_t)v), hi = __builtin_amdgcn_readfirstlane((uint32_t)(v >> 32));
  return (char*)(((uint64_t)hi << 32) | lo);
}
DI int launder_s(int v) { asm volatile("" : "+s"(v)); return v; }
DI int pi32(int i) { return (i & ~12) | ((i & 4) << 1) | ((i & 8) >> 1); }

struct LdPlain {
  const u16* p; int ld;
  DI const u16* operator()(int row, int k) const { return p + (uint32_t)(row * ld + k); }
};
DI int swz(int row, int ch) { return row * 128 + ((ch ^ ((row >> 1) & 7)) << 4); }
typedef __attribute__((address_space(3))) void lds_void;
DI void glds16(const u16* g, char* l) {
  __builtin_amdgcn_global_load_lds((const void*)g, (lds_void*)l, 16, 0, 0);
}
constexpr int STAGE_BYTES = 49152;
template <class LA, class LB>
DI void gemm_issue(const LA& la, const LB& lb, int k0, char* buf, uint32_t offA, uint32_t offB, int tid) {
#pragma unroll
  for (int i = 0; i < 4; ++i) {
    const u16* pa = la.p + (k0 + 64 * i * la.ld);
    glds16(pa + offA, buf + (tid + 512 * i) * 16);
  }
#pragma unroll
  for (int i = 0; i < 2; ++i) {
    const u16* pb = lb.p + (k0 + 64 * i * lb.ld);
    glds16(pb + offB, buf + 32768 + (tid + 512 * i) * 16);
  }
}
template <int OFF>
DI void lds_rd128(bf16x8& dst, uint32_t addr) {
  asm volatile("ds_read_b128 %0, %1 offset:%2" : "=v"(dst) : "v"(addr), "n"(OFF) : "memory");
}
#define LGKM_WAIT(N, a, b, c, d) asm volatile("s_waitcnt lgkmcnt(" #N ")" : "+v"(a), "+v"(b), "+v"(c), "+v"(d) :: "memory")
template <class LA, class LB>
DI void gemm_mainloop(f32x16 (&acc)[2][2], const LA& la, const LB& lb, int K, char* smem, int tid) {
  const int lane = tid & 63, w = tid >> 6, wm = w >> 1, wn = w & 1;
  const int n = lane & 31, h = lane >> 5;
  const int nk = K >> 6;
  const int row0 = tid >> 3, ch0 = (tid & 7) ^ ((row0 >> 1) & 7);
  const uint32_t offA = (uint32_t)(row0 * la.ld + ch0 * 8), offB = (uint32_t)(row0 * lb.ld + ch0 * 8);
  const uint32_t sbase = (uint32_t)(size_t)smem;
  const uint32_t fa0 = (uint32_t)swz(wm * 64 + n, h), fb0 = (uint32_t)swz(wn * 64 + n, h);
  gemm_issue(la, lb, 0, smem, offA, offB, tid);
  if (nk > 1) { gemm_issue(la, lb, 64, smem + STAGE_BYTES, offA, offB, tid); asm volatile("s_waitcnt vmcnt(6)" ::: "memory"); }
  else asm volatile("s_waitcnt vmcnt(0)" ::: "memory");
  __builtin_amdgcn_s_barrier();
  asm volatile("" ::: "memory");
  if (nk > 2) gemm_issue(la, lb, 128, smem + 2 * STAGE_BYTES, offA, offB, tid);
  bf16x8 af[2][2], bfr[2][2];
  lds_rd128<0>(af[0][0], sbase + fa0); lds_rd128<4096>(af[0][1], sbase + fa0);
  lds_rd128<32768>(bfr[0][0], sbase + fb0); lds_rd128<36864>(bfr[0][1], sbase + fb0);
  int st = 0;
#pragma unroll 1
  for (int kt = 0; kt < nk; ++kt) {
    const uint32_t sb_ = sbase + (uint32_t)(st * STAGE_BYTES);
    const int st1 = (st == 2) ? 0 : st + 1;
#pragma unroll
    for (int ks = 0; ks < 3; ++ks) {
      const int cur = ks & 1, nxt = cur ^ 1;
      const uint32_t aa = sb_ + (fa0 ^ (uint32_t)((ks + 1) << 5)), ab = sb_ + (fb0 ^ (uint32_t)((ks + 1) << 5));
      lds_rd128<0>(af[nxt][0], aa); lds_rd128<4096>(af[nxt][1], aa);
      lds_rd128<32768>(bfr[nxt][0], ab); lds_rd128<36864>(bfr[nxt][1], ab);
      LGKM_WAIT(4, af[cur][0], af[cur][1], bfr[cur][0], bfr[cur][1]);
#pragma unroll
      for (int mi = 0; mi < 2; ++mi)
#pragma unroll
        for (int ni = 0; ni < 2; ++ni) acc[mi][ni] = mfma32(af[cur][mi], bfr[cur][ni], acc[mi][ni]);
    }
    LGKM_WAIT(0, af[1][0], af[1][1], bfr[1][0], bfr[1][1]);
    if (kt + 1 < nk) {
      if (kt + 2 < nk) asm volatile("s_waitcnt vmcnt(6)" ::: "memory");
      else asm volatile("s_waitcnt vmcnt(0)" ::: "memory");
      __builtin_amdgcn_s_barrier();
      asm volatile("" ::: "memory");
      if (kt + 3 < nk) gemm_issue(la, lb, (kt + 3) * 64, smem + st * STAGE_BYTES, offA, offB, tid);
      const uint32_t sn = sbase + (uint32_t)(st1 * STAGE_BYTES);
      lds_rd128<0>(af[0][0], sn + fa0); lds_rd128<4096>(af[0][1], sn + fa0);
      lds_rd128<32768>(bfr[0][0], sn + fb0); lds_rd128<36864>(bfr[0][1], sn + fb0);
    }
#pragma unroll
    for (int mi = 0; mi < 2; ++mi)
#pragma unroll
      for (int ni = 0; ni < 2; ++ni) acc[mi][ni] = mfma32(af[1][mi], bfr[1][ni], acc[mi][ni]);
    st = st1;
  }
  __syncthreads();
}

constexpr int STAGE8_BYTES = 65536;
template <class LA, class LB>
DI void gemm_issue8(const LA& la, const LB& lb, int k0, char* buf, uint32_t offA, uint32_t offB, int tid) {
#pragma unroll
  for (int i = 0; i < 4; ++i) {
    const u16* pa = la.p + (k0 + 64 * i * la.ld);
    glds16(pa + offA, buf + (tid + 512 * i) * 16);
  }
#pragma unroll
  for (int i = 0; i < 4; ++i) {
    const u16* pb = lb.p + (k0 + 64 * i * lb.ld);
    glds16(pb + offB, buf + 32768 + (tid + 512 * i) * 16);
  }
}
#define LGKM_WAIT3(N, a, b, c) asm volatile("s_waitcnt lgkmcnt(" #N ")" : "+v"(a), "+v"(b), "+v"(c) :: "memory")
#define LGKM_WAIT1(N, a) asm volatile("s_waitcnt lgkmcnt(" #N ")" : "+v"(a) :: "memory")
template <class LA, class LB>
DI void gemm_mainloop8(f32x16 (&acc)[4][2], const LA& la, const LB& lb, int K, char* smem, int tid) {
  const int lane = tid & 63, w = tid >> 6, wm = w >> 2, wn = w & 3;
  const int n = lane & 31, h = lane >> 5;
  const int nk = K >> 6;
  const int row0 = tid >> 3, ch0 = (tid & 7) ^ ((row0 >> 1) & 7);
  const uint32_t offA = (uint32_t)(row0 * la.ld + ch0 * 8), offB = (uint32_t)(row0 * lb.ld + ch0 * 8);
  const uint32_t sbase = (uint32_t)(size_t)smem;
  const uint32_t fa0 = (uint32_t)swz(wm * 128 + n, h), fb0 = (uint32_t)swz(wn * 64 + n, h);
  gemm_issue8(la, lb, 0, smem, offA, offB, tid);
  asm volatile("s_waitcnt vmcnt(0)" ::: "memory");
  __builtin_amdgcn_s_barrier();
  asm volatile("" ::: "memory");
  if (nk > 1) gemm_issue8(la, lb, 64, smem + STAGE8_BYTES, offA, offB, tid);
  bf16x8 af[4], bfr[2][2];
  lds_rd128<32768>(bfr[0][0], sbase + fb0); lds_rd128<36864>(bfr[0][1], sbase + fb0);
  lds_rd128<0>(af[0], sbase + fa0); lds_rd128<4096>(af[1], sbase + fa0); lds_rd128<8192>(af[2], sbase + fa0); lds_rd128<12288>(af[3], sbase + fa0);
#pragma unroll 1
  for (int kt = 0; kt < nk; ++kt) {
    const uint32_t sb_ = sbase + (uint32_t)((kt & 1) * STAGE8_BYTES);
#pragma unroll
    for (int ks = 0; ks < 3; ++ks) {
      const int cur = ks & 1, nxt = cur ^ 1;
      const uint32_t aa = sb_ + (fa0 ^ (uint32_t)((ks + 1) << 5)), ab = sb_ + (fb0 ^ (uint32_t)((ks + 1) << 5));
      lds_rd128<32768>(bfr[nxt][0], ab); lds_rd128<36864>(bfr[nxt][1], ab);
      LGKM_WAIT3(5, af[0], bfr[cur][0], bfr[cur][1]);
      acc[0][0] = mfma32(af[0], bfr[cur][0], acc[0][0]); acc[0][1] = mfma32(af[0], bfr[cur][1], acc[0][1]);
      lds_rd128<0>(af[0], aa);
      LGKM_WAIT1(5, af[1]);
      acc[1][0] = mfma32(af[1], bfr[cur][0], acc[1][0]); acc[1][1] = mfma32(af[1], bfr[cur][1], acc[1][1]);
      lds_rd128<4096>(af[1], aa);
      LGKM_WAIT1(5, af[2]);
      acc[2][0] = mfma32(af[2], bfr[cur][0], acc[2][0]); acc[2][1] = mfma32(af[2], bfr[cur][1], acc[2][1]);
      lds_rd128<8192>(af[2], aa);
      LGKM_WAIT1(5, af[3]);
      acc[3][0] = mfma32(af[3], bfr[cur][0], acc[3][0]); acc[3][1] = mfma32(af[3], bfr[cur][1], acc[3][1]);
      lds_rd128<12288>(af[3], aa);
    }
    asm volatile("s_waitcnt lgkmcnt(0)" : "+v"(af[0]), "+v"(af[1]), "+v"(af[2]), "+v"(af[3]), "+v"(bfr[1][0]), "+v"(bfr[1][1]) :: "memory");
    const bool more = (kt + 1 < nk);
    const uint32_t sn = sbase + (uint32_t)(((kt + 1) & 1) * STAGE8_BYTES);
    if (more) {
      asm volatile("s_waitcnt vmcnt(0)" ::: "memory");
      __builtin_amdgcn_s_barrier();
      asm volatile("" ::: "memory");
      if (kt + 2 < nk) gemm_issue8(la, lb, (kt + 2) * 64, smem + (kt & 1) * STAGE8_BYTES, offA, offB, tid);
      lds_rd128<32768>(bfr[0][0], sn + fb0); lds_rd128<36864>(bfr[0][1], sn + fb0);
    }
    acc[0][0] = mfma32(af[0], bfr[1][0], acc[0][0]); acc[0][1] = mfma32(af[0], bfr[1][1], acc[0][1]);
    if (more) lds_rd128<0>(af[0], sn + fa0);
    acc[1][0] = mfma32(af[1], bfr[1][0], acc[1][0]); acc[1][1] = mfma32(af[1], bfr[1][1], acc[1][1]);
    if (more) lds_rd128<4096>(af[1], sn + fa0);
    acc[2][0] = mfma32(af[2], bfr[1][0], acc[2][0]); acc[2][1] = mfma32(af[2], bfr[1][1], acc[2][1]);
    if (more) lds_rd128<8192>(af[2], sn + fa0);
    acc[3][0] = mfma32(af[3], bfr[1][0], acc[3][0]); acc[3][1] = mfma32(af[3], bfr[1][1], acc[3][1]);
    if (more) lds_rd128<12288>(af[3], sn + fa0);
  }
  __syncthreads();
}
DI void zero_acc8(f32x16 (&acc)[4][2]) {
#pragma unroll
  for (int a = 0; a < 4; ++a)
#pragma unroll
    for (int b = 0; b < 2; ++b) acc[a][b] = zero16();
}

constexpr int CLD = 132;
DI void stage_half(const f32x16 (&acc)[4][2], float* Cs, int tid, int bj) {
  const int lane = tid & 63, w = tid >> 6, wm = w >> 2, wn = w & 3;
  const int n = lane & 31, h = lane >> 5;
  if ((wn >> 1) == bj) {
#pragma unroll
    for (int mi = 0; mi < 4; ++mi)
#pragma unroll
      for (int ni = 0; ni < 2; ++ni)
#pragma unroll
        for (int r = 0; r < 16; ++r) {
          int row = wm * 128 + mi * 32 + (r & 3) + 8 * (r >> 2) + 4 * h;
          int col = (wn & 1) * 64 + ni * 32 + n;
          Cs[row * CLD + col] = acc[mi][ni][r];
        }
  }
}
DI void stage_acc(const f32x16 (&acc)[2][2], float* Cs, int tid) {
  const int lane = tid & 63, w = tid >> 6, wm = w >> 1, wn = w & 1;
  const int n = lane & 31, h = lane >> 5;
#pragma unroll
  for (int mi = 0; mi < 2; ++mi)
#pragma unroll
    for (int ni = 0; ni < 2; ++ni)
#pragma unroll
      for (int r = 0; r < 16; ++r) {
        int row = wm * 64 + mi * 32 + (r & 3) + 8 * (r >> 2) + 4 * h;
        int col = wn * 64 + ni * 32 + n;
        Cs[row * CLD + col] = acc[mi][ni][r];
      }
}

template <int HD, bool NORM>
DI void epi_rowmajor(const float* Cs, u16* base, int H, int head0, const float* gain, float scale, int r, int SL, int tok0, int tid) {
  const int cc = tid & 15, c8 = cc * 8, hl = c8 / HD, d0 = c8 % HD;
  float g[8];
#pragma unroll
  for (int j = 0; j < 8; ++j) g[j] = NORM ? gain[d0 + j] * scale : scale;
  const int Lr = SL / r;
#pragma unroll 2
  for (int pass = 0; pass < 8; ++pass) {
    int row = (tid >> 4) + 32 * pass;
    float v[8];
    float4 v0 = *reinterpret_cast<const float4*>(Cs + row * CLD + c8);
    float4 v1 = *reinterpret_cast<const float4*>(Cs + row * CLD + c8 + 4);
    v[0] = v0.x; v[1] = v0.y; v[2] = v0.z; v[3] = v0.w; v[4] = v1.x; v[5] = v1.y; v[6] = v1.z; v[7] = v1.w;
    if (NORM) {
      float ss = 0.f;
#pragma unroll
      for (int j = 0; j < 8; ++j) ss += v[j] * v[j];
      ss += __shfl_xor(ss, 1); ss += __shfl_xor(ss, 2); ss += __shfl_xor(ss, 4);
      if (HD == 128) ss += __shfl_xor(ss, 8);
      float rstd = rsqrtf(ss * (1.f / HD) + 1e-6f);
#pragma unroll
      for (int j = 0; j < 8; ++j) v[j] *= rstd * g[j];
    } else {
#pragma unroll
      for (int j = 0; j < 8; ++j) v[j] *= g[j];
    }
    int token = tok0 + row, b = token / SL, t = token % SL;
    int pp = (t % r) * Lr + t / r;
    u16* dst = base + ((size_t)(b * H + head0 + hl) * SL + pp) * HD + d0;
    *reinterpret_cast<uint4*>(dst) = pack8(v);
  }
}
template <int HD, bool BLOCKED>
DI void epi_transposed(const float* Cs, u16* base, int H, int head0, int r, int SL, int tok0, int tid) {
  const int b = tok0 / SL, t0 = tok0 % SL, Lr = SL / r;
#pragma unroll 2
  for (int pass = 0; pass < 8; ++pass) {
    int u = tid + 512 * pass, col = u & 127, cj = u >> 7, c = cj % r, j = cj / r;
    float v[8];
#pragma unroll
    for (int e = 0; e < 8; ++e) v[e] = Cs[(c + r * (8 * j + e)) * CLD + col];
    int hl = col / HD, d = col % HD;
    int pp = c * Lr + t0 / r + 8 * j;
    u16* dst = BLOCKED ? base + ((size_t)(b * H + head0 + hl) * (SL >> 5) + (pp >> 5)) * (HD * 32) + d * 32 + (pp & 31)
                       : base + ((size_t)(b * H + head0 + hl) * HD + d) * SL + pp;
    *reinterpret_cast<uint4*>(dst) = pack8(v);
  }
}

DI void transpose_tile(const float* src, int N, u16* dst, int dst_ld, int tk, int tn, float* tile) {
  const int tid = threadIdx.x;
#pragma unroll
  for (int i = 0; i < 2; ++i) {
    int r = (tid >> 4) + 32 * i, c4 = (tid & 15) * 4;
    float4 v = *reinterpret_cast<const float4*>(src + (size_t)(tk * 64 + r) * N + tn * 64 + c4);
    tile[r * 65 + c4] = v.x; tile[r * 65 + c4 + 1] = v.y; tile[r * 65 + c4 + 2] = v.z; tile[r * 65 + c4 + 3] = v.w;
  }
  __syncthreads();
  {
    int nn = (tid >> 3), kc = (tid & 7) * 8;
    float v[8];
#pragma unroll
    for (int j = 0; j < 8; ++j) v[j] = tile[(kc + j) * 65 + nn];
    *reinterpret_cast<uint4*>(dst + (size_t)(tn * 64 + nn) * dst_ld + tk * 64 + kc) = pack8(v);
  }
  __syncthreads();
}
DI void rmsnorm_row(const float* src, const float* gain, u16* dst) {
  const int lane = threadIdx.x & 63;
  float4 v[4];
  float ss = 0.f;
#pragma unroll
  for (int i = 0; i < 4; ++i) {
    v[i] = *reinterpret_cast<const float4*>(src + i * 256 + lane * 4);
    ss += v[i].x * v[i].x + v[i].y * v[i].y + v[i].z * v[i].z + v[i].w * v[i].w;
  }
  ss = wave_sum(ss);
  float rstd = rsqrtf(ss * (1.f / 1024.f) + 1e-6f);
#pragma unroll
  for (int i = 0; i < 4; ++i) {
    float4 g = *reinterpret_cast<const float4*>(gain + i * 256 + lane * 4);
    uint2 o; o.x = pack2(v[i].x * rstd * g.x, v[i].y * rstd * g.y); o.y = pack2(v[i].z * rstd * g.z, v[i].w * rstd * g.w);
    *reinterpret_cast<uint2*>(dst + i * 256 + lane * 4) = o;
  }
}
DI void fp8_row(const float* src, unsigned char* dst, float* inv_scale) {
  const int lane = threadIdx.x & 63;
  float4 v[4];
  float am = 0.f;
#pragma unroll
  for (int i = 0; i < 4; ++i) {
    v[i] = *reinterpret_cast<const float4*>(src + lane * 16 + i * 4);
    am = fmaxf(am, fmaxf(fmaxf(fabsf(v[i].x), fabsf(v[i].y)), fmaxf(fabsf(v[i].z), fabsf(v[i].w))));
  }
#pragma unroll
  for (int o = 32; o; o >>= 1) am = fmaxf(am, __shfl_xor(am, o));
  float e = (am > 0.f) ? floorf(log2f(256.f / am)) : 0.f;
  e = fminf(fmaxf(e, -100.f), 100.f);
  const float sc = exp2f(e);
  uint4 o;
  unsigned* ow = reinterpret_cast<unsigned*>(&o);
#pragma unroll
  for (int i = 0; i < 4; ++i) {
    int w = __builtin_amdgcn_cvt_pk_fp8_f32(v[i].x * sc, v[i].y * sc, 0, false);
    w = __builtin_amdgcn_cvt_pk_fp8_f32(v[i].z * sc, v[i].w * sc, w, true);
    ow[i] = (unsigned)w;
  }
  *reinterpret_cast<uint4*>(dst + lane * 16) = o;
  if (lane == 0) *inv_scale = exp2f(-e);
}
DI void rmsnorm_row2(const float* s0, const float* g0, u16* d0, const float* s1, const float* g1, u16* d1) {
  const int lane = threadIdx.x & 63;
  float4 a[4], b[4];
#pragma unroll
  for (int i = 0; i < 4; ++i) { a[i] = *reinterpret_cast<const float4*>(s0 + i * 256 + lane * 4); b[i] = *reinterpret_cast<const float4*>(s1 + i * 256 + lane * 4); }
  float sa = 0.f, sb = 0.f;
#pragma unroll
  for (int i = 0; i < 4; ++i) {
    sa += a[i].x * a[i].x + a[i].y * a[i].y + a[i].z * a[i].z + a[i].w * a[i].w;
    sb += b[i].x * b[i].x + b[i].y * b[i].y + b[i].z * b[i].z + b[i].w * b[i].w;
  }
#pragma unroll
  for (int o = 32; o; o >>= 1) { sa += __shfl_xor(sa, o); sb += __shfl_xor(sb, o); }
  const float ra = rsqrtf(sa * (1.f / 1024.f) + 1e-6f), rb = rsqrtf(sb * (1.f / 1024.f) + 1e-6f);
#pragma unroll
  for (int i = 0; i < 4; ++i) {
    float4 ga = *reinterpret_cast<const float4*>(g0 + i * 256 + lane * 4);
    float4 gb = *reinterpret_cast<const float4*>(g1 + i * 256 + lane * 4);
    uint2 o; o.x = pack2(a[i].x * ra * ga.x, a[i].y * ra * ga.y); o.y = pack2(a[i].z * ra * ga.z, a[i].w * ra * ga.w);
    *reinterpret_cast<uint2*>(d0 + i * 256 + lane * 4) = o;
    o.x = pack2(b[i].x * rb * gb.x, b[i].y * rb * gb.y); o.y = pack2(b[i].z * rb * gb.z, b[i].w * rb * gb.w);
    *reinterpret_cast<uint2*>(d1 + i * 256 + lane * 4) = o;
  }
}
DI void fp8_row2(const float* s0, unsigned char* d0, float* i0, const float* s1, unsigned char* d1, float* i1) {
  const int lane = threadIdx.x & 63;
  float4 a[4], b[4];
#pragma unroll
  for (int i = 0; i < 4; ++i) { a[i] = *reinterpret_cast<const float4*>(s0 + lane * 16 + i * 4); b[i] = *reinterpret_cast<const float4*>(s1 + lane * 16 + i * 4); }
  float ma = 0.f, mb = 0.f;
#pragma unroll
  for (int i = 0; i < 4; ++i) {
    ma = fmaxf(ma, fmaxf(fmaxf(fabsf(a[i].x), fabsf(a[i].y)), fmaxf(fabsf(a[i].z), fabsf(a[i].w))));
    mb = fmaxf(mb, fmaxf(fmaxf(fabsf(b[i].x), fabsf(b[i].y)), fmaxf(fabsf(b[i].z), fabsf(b[i].w))));
  }
#pragma unroll
  for (int o = 32; o; o >>= 1) { ma = fmaxf(ma, __shfl_xor(ma, o)); mb = fmaxf(mb, __shfl_xor(mb, o)); }
  float ea = (ma > 0.f) ? floorf(log2f(256.f / ma)) : 0.f, eb = (mb > 0.f) ? floorf(log2f(256.f / mb)) : 0.f;
  ea = fminf(fmaxf(ea, -100.f), 100.f); eb = fminf(fmaxf(eb, -100.f), 100.f);
  const float sca = exp2f(ea), scb = exp2f(eb);
  uint4 oa, ob;
  unsigned* wa = reinterpret_cast<unsigned*>(&oa); unsigned* wb = reinterpret_cast<unsigned*>(&ob);
#pragma unroll
  for (int i = 0; i < 4; ++i) {
    int w = __builtin_amdgcn_cvt_pk_fp8_f32(a[i].x * sca, a[i].y * sca, 0, false);
    w = __builtin_amdgcn_cvt_pk_fp8_f32(a[i].z * sca, a[i].w * sca, w, true);
    wa[i] = (unsigned)w;
    w = __builtin_amdgcn_cvt_pk_fp8_f32(b[i].x * scb, b[i].y * scb, 0, false);
    w = __builtin_amdgcn_cvt_pk_fp8_f32(b[i].z * scb, b[i].w * scb, w, true);
    wb[i] = (unsigned)w;
  }
  *reinterpret_cast<uint4*>(d0 + (size_t)(lane >> 3) * (16384 * 128) + (lane & 7) * 16) = oa;
  *reinterpret_cast<uint4*>(d1 + (size_t)(lane >> 3) * (16384 * 128) + (lane & 7) * 16) = ob;
  if (lane == 0) { *i0 = exp2f(-ea); *i1 = exp2f(-eb); }
}
DI void convert_range(const float* src, u16* dst, size_t n8, size_t start, size_t stride) {
  for (size_t i = start; i < n8; i += stride) {
    float4 a = *reinterpret_cast<const float4*>(src + i * 8);
    float4 b = *reinterpret_cast<const float4*>(src + i * 8 + 4);
    uint4 o; o.x = pack2(a.x, a.y); o.y = pack2(a.z, a.w); o.z = pack2(b.x, b.y); o.w = pack2(b.z, b.w);
    *reinterpret_cast<uint4*>(dst + i * 8) = o;
  }
}

__device__ void phase0(const Params& p, int bid, int nb, char* smem) {
  float* tile = reinterpret_cast<float*>(smem);
  char* ws = p.ws;
  const int NTT = 1088 + 768 + 256 + 128 + 64 + 128 + 256 + 512;
  for (int it = bid; it < NTT; it += nb) {
    int i = it;
    const float* src; int N; u16* dst; int ld;
    if (i < 1088) { src = p.w_in; N = 4352; dst = (u16*)(ws + OFF_WINT); ld = 1024; }
    else if ((i -= 1088) < 768) { src = p.w_gate; N = 3072; dst = (u16*)(ws + OFF_WGT); ld = 1024; }
    else if ((i -= 768) < 256) { src = p.w_mem_kv; N = 1024; dst = (u16*)(ws + OFF_WKVT); ld = 1024; }
    else if ((i -= 256) < 128) { src = p.w_o_sb; N = 1024; dst = (u16*)(ws + OFF_WOT); ld = 1280; }
    else if ((i -= 128) < 64) { src = p.w_o_dil; N = 1024; dst = (u16*)(ws + OFF_WOT) + 512; ld = 1280; }
    else if ((i -= 64) < 128) { src = p.w_o_mem; N = 1024; dst = (u16*)(ws + OFF_WOT) + 768; ld = 1280; }
    else if ((i -= 128) < 256) { src = p.w_out; N = 1024; dst = (u16*)(ws + OFF_WOUTT); ld = 1024; }
    else { i -= 256; src = p.w_peer_q; N = 2048; dst = (u16*)(ws + OFF_WPQT); ld = 1024; }
    int ntn = N / 64;
    transpose_tile(src, N, dst, ld, i / ntn, i % ntn, tile);
  }
  const int w = __builtin_amdgcn_readfirstlane(threadIdx.x >> 6);
  u16* hbf = (u16*)((char*)p.out + OUT_OFF_H);
  u16* memh = (u16*)((char*)p.out + OUT_OFF_MEMH);
  {
    const int stride = nb * WPB;
    for (int row = bid * WPB + w; row < T_ + 2048; row += 2 * stride) {
      const int r1 = row + stride;
      const float* s0 = (row < T_) ? p.x + (size_t)row * 1024 : p.mem + (size_t)(row - T_) * 1024;
      const float* g0 = (row < T_) ? p.g_mix : p.g_mem;
      u16* d0 = (row < T_) ? hbf + (size_t)row * 1024 : memh + (size_t)(row - T_) * 1024;
      if (r1 < T_ + 2048) {
        const float* s1 = (r1 < T_) ? p.x + (size_t)r1 * 1024 : p.mem + (size_t)(r1 - T_) * 1024;
        const float* g1 = (r1 < T_) ? p.g_mix : p.g_mem;
        u16* d1 = (r1 < T_) ? hbf + (size_t)r1 * 1024 : memh + (size_t)(r1 - T_) * 1024;
        rmsnorm_row2(s0, g0, d0, s1, g1, d1);
      } else rmsnorm_row(s0, g0, d0);
    }
  }
  convert_range(p.subkeys, (u16*)(ws + OFF_SUBK), 262144 / 8, (size_t)bid * NTHR + threadIdx.x, (size_t)nb * NTHR);
  float* usc = (float*)(ws + OFF_USC);
  if (nb * 70 < 16384)
  for (int row = bid * WPB + w; row < 16384; row += nb * WPB)
    fp8_row2(p.peer_u + (size_t)row * 1024, (unsigned char*)(ws + OFF_U8) + (size_t)row * 128, usc + row * 2,
             p.peer_v + (size_t)row * 1024, (unsigned char*)(ws + OFF_V8) + (size_t)row * 128, usc + row * 2 + 1);
}

DI void p1_epilogue(const Params& p, char* ws, const float* Cs, int c0, int tok0, int kv, int tid) {
  if (!kv) {
    if (c0 < 512) epi_rowmajor<64, false>(Cs, (u16*)(ws + OFF_QSB), 8, c0 / 64, nullptr, 0.125f, 1, 2048, tok0, tid);
    else if (c0 < 1024) epi_rowmajor<64, false>(Cs, (u16*)(ws + OFF_KSB), 8, (c0 - 512) / 64, nullptr, 1.f, 1, 2048, tok0, tid);
    else if (c0 < 1536) epi_transposed<64, true>(Cs, (u16*)(ws + OFF_VTSB), 8, (c0 - 1024) / 64, 1, 2048, tok0, tid);
    else if (c0 < 2304) { int h0 = (c0 - 1536) / 64; epi_rowmajor<64, true>(Cs, (u16*)(ws + OFF_QD), 12, h0, p.g_q_dil, 0.125f, 1 << (2 * (h0 >> 2)), 2048, tok0, tid); }
    else if (c0 < 3072) { int h0 = (c0 - 2304) / 64; epi_rowmajor<64, true>(Cs, (u16*)(ws + OFF_KD), 12, h0, p.g_k_dil, 1.f, 1 << (2 * (h0 >> 2)), 2048, tok0, tid); }
    else if (c0 < 3840) { int h0 = (c0 - 3072) / 64; epi_transposed<64, true>(Cs, (u16*)(ws + OFF_VTD), 12, h0, 1 << (2 * (h0 >> 2)), 2048, tok0, tid); }
    else epi_rowmajor<128, true>(Cs, (u16*)(ws + OFF_QM), 4, (c0 - 3840) / 128, p.g_q_mem, 0.08838834764831845f, 1, 2048, tok0, tid);
  } else {
    if (c0 < 512) epi_rowmajor<128, true>(Cs, (u16*)(ws + OFF_KM), 4, c0 / 128, p.g_k_mem, 1.f, 1, 256, tok0, tid);
    else epi_transposed<128, false>(Cs, (u16*)(ws + OFF_VTM), 4, (c0 - 512) / 128, 1, 256, tok0, tid);
  }
}
__device__ void phase1(const Params& p, int bid, int nb, char* smem) {
  char* ws = p.ws;
  float* Cs = reinterpret_cast<float*>(smem);
  const u16* hbf = (const u16*)((char*)p.out + OUT_OFF_H);
  const u16* memh = (const u16*)((char*)p.out + OUT_OFF_MEMH);
  const int xcd = bid & 7, lb = bid >> 3, nlb = (nb + 7 - xcd) >> 3;
  for (int li = lb; li < 128; li += nlb) {
    const int tid = launder(threadIdx.x);
    f32x16 acc[4][2];
    zero_acc8(acc);
    const int tm = li >> 1, tn = 2 * xcd + (li & 1);
    gemm_mainloop8(acc, LdPlain{hbf + (size_t)tm * 256 * 1024, 1024}, LdPlain{(const u16*)(ws + OFF_WINT) + (size_t)tn * 256 * 1024, 1024}, 1024, smem, tid);
#pragma unroll 1
    for (int bj = 0; bj < 2; ++bj) {
      stage_half(acc, Cs, tid, bj);
      __syncthreads();
      p1_epilogue(p, ws, Cs, tn * 256 + bj * 128, tm * 256, 0, tid);
      __syncthreads();
    }
  }
  for (int hi = lb; hi < 24; hi += nlb) {
    const int tid = launder(threadIdx.x);
    f32x16 acc[2][2];
#pragma unroll
    for (int a = 0; a < 2; ++a)
#pragma unroll
      for (int b = 0; b < 2; ++b) acc[a][b] = zero16();
    int kv, tm, c0;
    if (hi < 16) { kv = 0; tm = 8 * xcd + (hi >> 1); c0 = 16 * 256 + (hi & 1) * 128; }
    else { kv = 1; tm = xcd; c0 = (hi - 16) * 128; }
    if (!kv) gemm_mainloop(acc, LdPlain{hbf + (size_t)tm * 256 * 1024, 1024}, LdPlain{(const u16*)(ws + OFF_WINT) + (size_t)c0 * 1024, 1024}, 1024, smem, tid);
    else gemm_mainloop(acc, LdPlain{memh + (size_t)tm * 256 * 1024, 1024}, LdPlain{(const u16*)(ws + OFF_WKVT) + (size_t)c0 * 1024, 1024}, 1024, smem, tid);
    stage_acc(acc, Cs, tid);
    __syncthreads();
    p1_epilogue(p, ws, Cs, c0, tm * 256, kv, tid);
    __syncthreads();
  }
}

DI void pack_p(const float* a, bf16x8& p0, bf16x8& p1) {
  uint4 u0 = pack8(a), u1 = pack8(a + 8);
  p0 = as_bf16x8(u0); p1 = as_bf16x8(u1);
}
DI void write_ot(const f32x16& o, float scale, u16* rowp, int db, int h) {
#pragma unroll
  for (int g = 0; g < 4; ++g) {
    uint2 v; v.x = pack2(o[4 * g] * scale, o[4 * g + 1] * scale); v.y = pack2(o[4 * g + 2] * scale, o[4 * g + 3] * scale);
    *reinterpret_cast<uint2*>(rowp + 32 * db + 8 * g + 4 * h) = v;
  }
}

#define KV_DECL uint4 sk0, sk1, sk2, sk3, sv0, sv1, sv2, sv3;
#define KV_FETCH(Kb, Vb, key0) { \
    const char* kp_ = reinterpret_cast<const char*>(Kb) + (uint32_t)((key0) * 128 + lane * 16); \
    const char* vp_ = reinterpret_cast<const char*>(Vb) + (uint32_t)(((key0) >> 5) * 4096 + lane * 16); \
    sk0 = *reinterpret_cast<const uint4*>(kp_); sk1 = *reinterpret_cast<const uint4*>(kp_ + 1024); \
    sk2 = *reinterpret_cast<const uint4*>(kp_ + 2048); sk3 = *reinterpret_cast<const uint4*>(kp_ + 3072); \
    sv0 = *reinterpret_cast<const uint4*>(vp_); sv1 = *reinterpret_cast<const uint4*>(vp_ + 1024); \
    sv2 = *reinterpret_cast<const uint4*>(vp_ + 2048); sv3 = *reinterpret_cast<const uint4*>(vp_ + 3072); }
#define KV_PARK(lk) { \
    char* lv_ = (lk) + 4096; const int kr_ = lane >> 3, kc_ = lane & 7, vd_ = lane >> 2, vq_ = lane & 3; \
    *reinterpret_cast<uint4*>((lk) + swz(kr_, kc_)) = sk0; *reinterpret_cast<uint4*>((lk) + swz(kr_ + 8, kc_)) = sk1; \
    *reinterpret_cast<uint4*>((lk) + swz(kr_ + 16, kc_)) = sk2; *reinterpret_cast<uint4*>((lk) + swz(kr_ + 24, kc_)) = sk3; \
    *reinterpret_cast<uint4*>(lv_ + vd_ * 64 + ((vq_ ^ ((vd_ >> 2) & 3)) << 4)) = sv0; \
    *reinterpret_cast<uint4*>(lv_ + (vd_ + 16) * 64 + ((vq_ ^ (((vd_ + 16) >> 2) & 3)) << 4)) = sv1; \
    *reinterpret_cast<uint4*>(lv_ + (vd_ + 32) * 64 + ((vq_ ^ (((vd_ + 32) >> 2) & 3)) << 4)) = sv2; \
    *reinterpret_cast<uint4*>(lv_ + (vd_ + 48) * 64 + ((vq_ ^ (((vd_ + 48) >> 2) & 3)) << 4)) = sv3; }
DI void kv_frags(bf16x8 (&kf)[4], bf16x8 (&vf)[2][2], const char* lk, int pin, int n, int h) {
  const char* lv = lk + 4096;
#pragma unroll
  for (int ks = 0; ks < 4; ++ks) kf[ks] = *reinterpret_cast<const bf16x8*>(lk + swz(pin, 4 * h + ks));
#pragma unroll
  for (int db = 0; db < 2; ++db)
#pragma unroll
    for (int s = 0; s < 2; ++s) {
      const int d = 32 * db + n;
      vf[db][s] = *reinterpret_cast<const bf16x8*>(lv + d * 64 + (((2 * s + h) ^ ((d >> 2) & 3)) << 4));
    }
}

__device__ void sb_task(const char* ws, char* outb, char* lk, int b, int hd, int qt) {
  const int lane = threadIdx.x & 63, n = lane & 31, h = lane >> 5;
  const u16* Qb = (const u16*)(ws + OFF_QSB) + (size_t)(b * 8 + hd) * 2048 * 64;
  const u16* Kb = (const u16*)(ws + OFF_KSB) + (size_t)(b * 8 + hd) * 2048 * 64;
  const u16* Vb = (const u16*)(ws + OFF_VTSB) + (size_t)(b * 8 + hd) * 64 * 2048;
  const int q0 = qt * 32;
  bf16x8 qf[4];
#pragma unroll
  for (int ks = 0; ks < 4; ++ks) qf[ks] = ld16(Qb + (uint32_t)((q0 + n) * 64 + 32 * h + 8 * ks));
  f32x16 o0 = zero16(), o1 = zero16();
  float carry = 0.f;
  const int pin = pi32(n);
  KV_DECL
  KV_FETCH(Kb, Vb, q0)
  for (int kb = qt; kb >= 0; --kb) {
    KV_PARK(lk)
    KV_FETCH(Kb, Vb, (kb > 0 ? kb - 1 : 0) * 32)
    bf16x8 kf[4], vf[2][2];
    kv_frags(kf, vf, lk, pin, n, h);
    f32x16 z = zero16();
#pragma unroll
    for (int ks = 0; ks < 4; ++ks) z = mfma32(kf[ks], qf[ks], z);
    const bool diag = (kb == qt);
    float sp[16], E[16];
#pragma unroll
    for (int r = 0; r < 16; ++r) {
      int kl = 16 * (r >> 3) + 8 * h + (r & 7);
      bool valid = (!diag) || (kl < n);
      float zz = z[r];
      float e = __expf(-fabsf(zz));
      float s = fmaxf(zz, 0.f) + __logf(1.f + e);
      sp[r] = valid ? s : 0.f;
    }
    E[7] = 0.f; E[15] = 0.f;
#pragma unroll
    for (int r = 6; r >= 0; --r) { E[r] = E[r + 1] + sp[r + 1]; E[r + 8] = E[r + 9] + sp[r + 9]; }
    float A0 = E[0] + sp[0], A1 = E[8] + sp[8];
    float B0 = __shfl_xor(A0, 32), B1 = __shfl_xor(A1, 32);
    float after0 = h ? (B1 + A1) : (B0 + A1 + B1);
    float after1 = h ? 0.f : B1;
    float a[16];
#pragma unroll
    for (int r = 0; r < 16; ++r) {
      int kl = 16 * (r >> 3) + 8 * h + (r & 7);
      bool valid = (!diag) || (kl < n);
      float bet = carry + ((r < 8) ? after0 : after1) + E[r];
      float v = __expf(z[r] - sp[r] - bet);
      a[r] = valid ? v : 0.f;
    }
    carry += A0 + A1 + B0 + B1;
    bf16x8 p0, p1;
    pack_p(a, p0, p1);
    o0 = mfma32(vf[0][0], p0, o0); o0 = mfma32(vf[0][1], p1, o0);
    o1 = mfma32(vf[1][0], p0, o1); o1 = mfma32(vf[1][1], p1, o1);
    if (__all(carry > 104.f)) break;
  }
  u16* rowp = (u16*)(outb + OUT_OFF_YSB) + (size_t)(b * 2048 + q0 + n) * 512 + hd * 64;
  write_ot(o0, 1.f, rowp, 0, h);
  write_ot(o1, 1.f, rowp, 1, h);
}

__device__ void dil_task(const char* ws, char* outb, char* lk, int b, int head, int pt) {
  const int lane = threadIdx.x & 63, n = lane & 31, h = lane >> 5;
  const int g = head >> 2, r_ = 1 << (2 * g), L = 2048 / r_;
  const int p0 = pt * 32, c = p0 / L, i0 = p0 % L;
  const float slope = exp2f(-8.f * (float)(head + 1) / 12.f) * (float)r_;
  const u16* Qb = (const u16*)(ws + OFF_QD) + (size_t)(b * 12 + head) * 2048 * 64;
  const u16* Kb = (const u16*)(ws + OFF_KD) + (size_t)(b * 12 + head) * 2048 * 64;
  const u16* Vb = (const u16*)(ws + OFF_VTD) + (size_t)(b * 12 + head) * 64 * 2048;
  bf16x8 qf[4];
#pragma unroll
  for (int ks = 0; ks < 4; ++ks) qf[ks] = ld16(Qb + (uint32_t)((p0 + n) * 64 + 32 * h + 8 * ks));
  f32x16 o0 = zero16(), o1 = zero16();
  float m = -1e30f, lsum = 0.f;
  const int pin = pi32(n);
  KV_DECL
  KV_FETCH(Kb, Vb, p0)
  for (int rel = 0; rel >= -4; --rel) {
    const int ib = i0 + 32 * rel;
    if (ib < 0) break;
    KV_PARK(lk)
    KV_FETCH(Kb, Vb, c * L + ((ib >= 32) ? ib - 32 : ib))
    bf16x8 kf[4], vf[2][2];
    kv_frags(kf, vf, lk, pin, n, h);
    f32x16 z = zero16();
#pragma unroll
    for (int ks = 0; ks < 4; ++ks) z = mfma32(kf[ks], qf[ks], z);
    float s[16];
    float bm = -1e30f;
#pragma unroll
    for (int r = 0; r < 16; ++r) {
      int kl = 16 * (r >> 3) + 8 * h + (r & 7);
      int gap = n - kl - 32 * rel;
      bool valid = (gap >= 0) && (gap <= 128);
      s[r] = valid ? (z[r] - slope * (float)gap) : -1e30f;
      bm = fmaxf(bm, s[r]);
    }
    bm = fmaxf(bm, __shfl_xor(bm, 32));
    float mn = fmaxf(m, bm);
    float alpha = __expf(m - mn);
    float a[16];
    float ps = 0.f;
#pragma unroll
    for (int r = 0; r < 16; ++r) { a[r] = __expf(s[r] - mn); ps += a[r]; }
    lsum = lsum * alpha + ps;
#pragma unroll
    for (int r = 0; r < 16; ++r) { o0[r] *= alpha; o1[r] *= alpha; }
    m = mn;
    bf16x8 p0, p1;
    pack_p(a, p0, p1);
    o0 = mfma32(vf[0][0], p0, o0); o0 = mfma32(vf[0][1], p1, o0);
    o1 = mfma32(vf[1][0], p0, o1); o1 = mfma32(vf[1][1], p1, o1);
  }
  float ltot = lsum + __shfl_xor(lsum, 32);
  float inv = 1.f / ltot;
  int t = c + r_ * (i0 + n);
  size_t token = (size_t)b * 2048 + t;
  u16* rowp = (u16*)(ws + OFF_YD) + (token * 12 + head) * 64;
  write_ot(o0, inv, rowp, 0, h);
  write_ot(o1, inv, rowp, 1, h);
  if (h == 0) ((float*)(outb + OUT_OFF_LSE))[token * 12 + head] = m + __logf(ltot);
}

__device__ void mem_block_task(const char* ws, char* smem, int b, int hm, int qgrp) {
  const int tid = threadIdx.x, lane = tid & 63, w = tid >> 6, n = lane & 31, h = lane >> 5;
  const u16* Qb = (const u16*)(ws + OFF_QM) + (size_t)(b * 4 + hm) * 2048 * 128;
  const char* Kg = ws + OFF_KM + (size_t)(b * 4 + hm) * 256 * 128 * 2;
  const char* Vg = ws + OFF_VTM + (size_t)(b * 4 + hm) * 128 * 256 * 2;
  char* lk = smem;
  char* lv = smem + 65536;
#pragma unroll
  for (int i = 0; i < 8; ++i) {
    const int idx = tid + 512 * i;
    const int kr = idx >> 4, kc = idx & 15;
    const uint4 kv = *reinterpret_cast<const uint4*>(Kg + (uint32_t)idx * 16u);
    const int vd = idx >> 5, vc = idx & 31;
    const uint4 vv = *reinterpret_cast<const uint4*>(Vg + (uint32_t)idx * 16u);
    *reinterpret_cast<uint4*>(lk + kr * 256 + ((kc ^ (kr & 15)) << 4)) = kv;
    *reinterpret_cast<uint4*>(lv + vd * 512 + ((vc ^ (vd & 15)) << 4)) = vv;
  }
  const int q0 = (qgrp * 8 + w) * 32;
  bf16x8 qf[8];
#pragma unroll
  for (int ks = 0; ks < 8; ++ks) qf[ks] = ld16(Qb + (uint32_t)((q0 + n) * 128 + 64 * h + 8 * ks));
  __syncthreads();
  f32x16 o[4];
#pragma unroll
  for (int db = 0; db < 4; ++db) o[db] = zero16();
  float m = -1e30f, lsum = 0.f;
  const int pin = pi32(n);
  for (int kb = 0; kb < 8; ++kb) {
    const int krow = kb * 32 + pin;
    const char* kp = lk + krow * 256;
    f32x16 z = zero16();
#pragma unroll
    for (int ks = 0; ks < 8; ++ks) z = mfma32(*reinterpret_cast<const bf16x8*>(kp + (((8 * h + ks) ^ (krow & 15)) << 4)), qf[ks], z);
    float bm = -1e30f;
#pragma unroll
    for (int r = 0; r < 16; ++r) bm = fmaxf(bm, z[r]);
    bm = fmaxf(bm, __shfl_xor(bm, 32));
    float mn = fmaxf(m, bm);
    float alpha = __expf(m - mn);
    float a[16];
    float ps = 0.f;
#pragma unroll
    for (int r = 0; r < 16; ++r) { a[r] = __expf(z[r] - mn); ps += a[r]; }
    lsum = lsum * alpha + ps;
    m = mn;
    bf16x8 p0, p1;
    pack_p(a, p0, p1);
#pragma unroll
    for (int db = 0; db < 4; ++db) {
      const int d = 32 * db + n;
      const char* vp = lv + d * 512;
      bf16x8 vf0 = *reinterpret_cast<const bf16x8*>(vp + (((4 * kb + h) ^ (d & 15)) << 4));
      bf16x8 vf1 = *reinterpret_cast<const bf16x8*>(vp + (((4 * kb + 2 + h) ^ (d & 15)) << 4));
#pragma unroll
      for (int r = 0; r < 16; ++r) o[db][r] *= alpha;
      o[db] = mfma32(vf0, p0, o[db]);
      o[db] = mfma32(vf1, p1, o[db]);
    }
  }
  float ltot = lsum + __shfl_xor(lsum, 32);
  float inv = 1.f / ltot;
  u16* rowp = (u16*)(ws + OFF_YM) + (size_t)(b * 2048 + q0 + n) * 512 + hm * 128;
#pragma unroll
  for (int db = 0; db < 4; ++db) write_ot(o[db], inv, rowp, db, h);
  __syncthreads();
}

__device__ void phase2(const Params& p, int bid, int nb, char* smem) {
  const char* ws = p.ws;
  const int w = __builtin_amdgcn_readfirstlane(threadIdx.x >> 6);
  const int gw = bid * WPB + w, nw = nb * WPB;
  char* lk = smem + w * 8192;
  for (int bt = bid; bt < 256; bt += nb) mem_block_task(ws, smem, bt >> 5, (bt >> 3) & 3, bt & 7);
  for (int task = gw; task < 4096 + 6144; task += nw) {
    if (task < 4096) {
      int qt = 63 - (task >> 6), bh = task & 63;
      sb_task(ws, (char*)p.out, lk, bh >> 3, bh & 7, qt);
    } else {
      int i = task - 4096;
      int pt = i & 63, bh = i >> 6;
      dil_task(ws, (char*)p.out, lk, bh / 12, bh % 12, pt);
    }
  }
}

__device__ void phase2b(const Params& p, int bid, int nb) {
  char* ws = p.ws;
  const size_t gt = (size_t)bid * NTHR + threadIdx.x, gs = (size_t)nb * NTHR;
  const u16* Yd = (const u16*)(ws + OFF_YD);
  const float* LSE = (const float*)((char*)p.out + OUT_OFF_LSE);
  u16* Ydm = (u16*)((char*)p.out + OUT_OFF_YDM);
  for (size_t i = gt; i < (size_t)T_ * 32; i += gs) {
    size_t t = i >> 5; int c = (int)(i & 31), hg = c >> 3, d0 = (c & 7) * 8;
    float l0 = LSE[t * 12 + hg], l1 = LSE[t * 12 + 4 + hg], l2 = LSE[t * 12 + 8 + hg];
    float mx = fmaxf(l0, fmaxf(l1, l2));
    float e0 = __expf(l0 - mx), e1 = __expf(l1 - mx), e2 = __expf(l2 - mx);
    float inv = 1.f / (e0 + e1 + e2);
    float wg[3] = {e0 * inv, e1 * inv, e2 * inv};
    float acc[8];
#pragma unroll
    for (int j = 0; j < 8; ++j) acc[j] = 0.f;
#pragma unroll
    for (int g = 0; g < 3; ++g) {
      uint4 v = *reinterpret_cast<const uint4*>(Yd + (t * 12 + g * 4 + hg) * 64 + d0);
      acc[0] += wg[g] * bf_lo(v.x); acc[1] += wg[g] * bf_hi(v.x); acc[2] += wg[g] * bf_lo(v.y); acc[3] += wg[g] * bf_hi(v.y);
      acc[4] += wg[g] * bf_lo(v.z); acc[5] += wg[g] * bf_hi(v.z); acc[6] += wg[g] * bf_lo(v.w); acc[7] += wg[g] * bf_hi(v.w);
    }
    *reinterpret_cast<uint4*>(Ydm + t * 256 + c * 8) = pack8(acc);
  }
}

__device__ void phase3(const Params& p, int bid, int nb, char* smem) {
  char* ws = p.ws;
  float* Cs = reinterpret_cast<float*>(smem);
  const u16* hbf = (const u16*)((char*)p.out + OUT_OFF_H);
  const int xcd = bid & 7, lb = bid >> 3, nlb = (nb + 7 - xcd) >> 3;
  for (int li = lb; li < 64; li += nlb) {
    const int tid = launder(threadIdx.x);
    const int lane = tid & 63, w = tid >> 6, wn = w & 1, n = lane & 31;
    const int tm = 8 * xcd + (li >> 3), tn = li & 7;
#pragma unroll 1
    for (int br = 0; br < 3; ++br) {
      f32x16 acc[2][2];
#pragma unroll
      for (int a = 0; a < 2; ++a)
#pragma unroll
        for (int b = 0; b < 2; ++b) acc[a][b] = zero16();
      gemm_mainloop(acc, LdPlain{hbf + (size_t)tm * 256 * 1024, 1024},
                    LdPlain{(const u16*)(ws + OFF_WGT) + (size_t)(br * 1024 + tn * 128) * 1024, 1024}, 1024, smem, tid);
      char* gscr = uniform_ptr(ws + OFF_GSCR + (size_t)bid * (NTHR * 8 * 16));
      const uint32_t toff = (uint32_t)tid * 16u;
#pragma unroll
      for (int mi = 0; mi < 2; ++mi)
#pragma unroll
        for (int ni = 0; ni < 2; ++ni) {
          float bias = p.b_gate[br * 1024 + tn * 128 + wn * 64 + ni * 32 + n];
#pragma unroll
          for (int q4 = 0; q4 < 2; ++q4) {
            uint32_t pk[4];
#pragma unroll
            for (int r = 0; r < 4; ++r) {
              float g0 = __builtin_amdgcn_rcpf(1.f + __expf(-(acc[mi][ni][8 * q4 + 2 * r] + bias)));
              float g1 = __builtin_amdgcn_rcpf(1.f + __expf(-(acc[mi][ni][8 * q4 + 2 * r + 1] + bias)));
              pk[r] = pack2(g0, g1);
            }
            *reinterpret_cast<uint4*>(gscr + ((mi * 2 + ni) * 2 + q4) * (NTHR * 16) + toff) = make_uint4(pk[0], pk[1], pk[2], pk[3]);
            __builtin_amdgcn_sched_barrier(0);
          }
        }
#pragma unroll
      for (int a = 0; a < 2; ++a)
#pragma unroll
        for (int b = 0; b < 2; ++b) acc[a][b] = zero16();
      const u16* Y; int ldy, Kb, koff;
      if (br == 0) { Y = (const u16*)((char*)p.out + OUT_OFF_YSB); ldy = 512; Kb = 512; koff = 0; }
      else if (br == 1) { Y = (const u16*)((char*)p.out + OUT_OFF_YDM); ldy = 256; Kb = 256; koff = 512; }
      else { Y = (const u16*)(ws + OFF_YM); ldy = 512; Kb = 512; koff = 768; }
      gemm_mainloop(acc, LdPlain{Y + (size_t)tm * 256 * ldy, ldy},
                    LdPlain{(const u16*)(ws + OFF_WOT) + (size_t)(tn * 128) * 1280 + koff, 1280}, Kb, smem, tid);
      char* tpark = uniform_ptr(ws + OFF_TPARK + (size_t)bid * (NTHR * 16 * 16));
#define P3_COMBINE(LOADP, STOREP) \
      _Pragma("unroll") for (int mi = 0; mi < 2; ++mi) \
      _Pragma("unroll") for (int ni = 0; ni < 2; ++ni) \
      _Pragma("unroll") for (int q4 = 0; q4 < 2; ++q4) { \
            uint4 gv = *reinterpret_cast<const uint4*>(gscr + ((mi * 2 + ni) * 2 + q4) * (NTHR * 16) + toff); \
            const uint32_t gw[4] = {gv.x, gv.y, gv.z, gv.w}; \
            _Pragma("unroll") for (int hf = 0; hf < 2; ++hf) { \
              float4 v; \
              v.x = bf_lo(gw[2 * hf]) * acc[mi][ni][8 * q4 + 4 * hf]; v.y = bf_hi(gw[2 * hf]) * acc[mi][ni][8 * q4 + 4 * hf + 1]; \
              v.z = bf_lo(gw[2 * hf + 1]) * acc[mi][ni][8 * q4 + 4 * hf + 2]; v.w = bf_hi(gw[2 * hf + 1]) * acc[mi][ni][8 * q4 + 4 * hf + 3]; \
              if (LOADP) { float4 t4 = *reinterpret_cast<const float4*>(tpark + (((mi * 2 + ni) * 2 + q4) * 2 + hf) * (NTHR * 16) + toff); v.x += t4.x; v.y += t4.y; v.z += t4.z; v.w += t4.w; } \
              if (STOREP) *reinterpret_cast<float4*>(tpark + (((mi * 2 + ni) * 2 + q4) * 2 + hf) * (NTHR * 16) + toff) = v; \
              acc[mi][ni][8 * q4 + 4 * hf] = v.x; acc[mi][ni][8 * q4 + 4 * hf + 1] = v.y; acc[mi][ni][8 * q4 + 4 * hf + 2] = v.z; acc[mi][ni][8 * q4 + 4 * hf + 3] = v.w; \
            } \
            __builtin_amdgcn_sched_barrier(0); \
      }
      if (br == 0) { P3_COMBINE(false, true) }
      else if (br == 1) { P3_COMBINE(true, true) }
      else { P3_COMBINE(true, false) }
      if (br == 2) stage_acc(acc, Cs, tid);
    }
    __syncthreads();
    {
      const int c8 = (tid & 15) * 8;
      u16* M = (u16*)(ws + OFF_MERGED);
#pragma unroll 2
      for (int pass = 0; pass < 8; ++pass) {
        int row = (tid >> 4) + 32 * pass;
        float v[8];
        float4 v0 = *reinterpret_cast<const float4*>(Cs + row * CLD + c8);
        float4 v1 = *reinterpret_cast<const float4*>(Cs + row * CLD + c8 + 4);
        v[0] = v0.x; v[1] = v0.y; v[2] = v0.z; v[3] = v0.w; v[4] = v1.x; v[5] = v1.y; v[6] = v1.z; v[7] = v1.w;
        *reinterpret_cast<uint4*>(M + (size_t)(tm * 256 + row) * 1024 + tn * 128 + c8) = pack8(v);
      }
    }
    __syncthreads();
  }
}

__device__ void phase4(const Params& p, int bid, int nb, char* smem) {
  char* ws = p.ws;
  float* Cs = reinterpret_cast<float*>(smem);
  const int xcd = bid & 7, lb = bid >> 3, nlb = (nb + 7 - xcd) >> 3;
  for (int li = lb; li < 32; li += nlb) {
    const int tid = launder(threadIdx.x);
    const int tm = 8 * xcd + (li >> 2), tn = li & 3;
    f32x16 acc[4][2];
    zero_acc8(acc);
    gemm_mainloop8(acc, LdPlain{(const u16*)(ws + OFF_MERGED) + (size_t)tm * 256 * 1024, 1024},
                  LdPlain{(const u16*)(ws + OFF_WOUTT) + (size_t)(tn * 256) * 1024, 1024}, 1024, smem, tid);
#pragma unroll 1
    for (int bj = 0; bj < 2; ++bj) {
      stage_half(acc, Cs, tid, bj);
      __syncthreads();
      const int c8 = (tid & 15) * 8, tn8 = tn * 2 + bj;
      u16* XG = (u16*)(ws + OFF_XG);
      float* rowss = (float*)(ws + OFF_ROWSS);
      const float4 g0 = *reinterpret_cast<const float4*>(p.g_ffn + tn8 * 128 + c8);
      const float4 g1 = *reinterpret_cast<const float4*>(p.g_ffn + tn8 * 128 + c8 + 4);
#pragma unroll 2
      for (int pass = 0; pass < 8; ++pass) {
        int row = (tid >> 4) + 32 * pass;
        size_t off = (size_t)(tm * 256 + row) * 1024 + tn8 * 128 + c8;
        float4 v0 = *reinterpret_cast<const float4*>(Cs + row * CLD + c8);
        float4 v1 = *reinterpret_cast<const float4*>(Cs + row * CLD + c8 + 4);
        float4 x0 = *reinterpret_cast<const float4*>(p.x + off);
        float4 x1 = *reinterpret_cast<const float4*>(p.x + off + 4);
        v0.x += x0.x; v0.y += x0.y; v0.z += x0.z; v0.w += x0.w;
        v1.x += x1.x; v1.y += x1.y; v1.z += x1.z; v1.w += x1.w;
        *reinterpret_cast<float4*>(p.out + off) = v0;
        *reinterpret_cast<float4*>(p.out + off + 4) = v1;
        float ss = v0.x * v0.x + v0.y * v0.y + v0.z * v0.z + v0.w * v0.w + v1.x * v1.x + v1.y * v1.y + v1.z * v1.z + v1.w * v1.w;
        ss += __shfl_xor(ss, 1); ss += __shfl_xor(ss, 2); ss += __shfl_xor(ss, 4); ss += __shfl_xor(ss, 8);
        if ((tid & 15) == 0) rowss[(size_t)(tm * 256 + row) * 8 + tn8] = ss;
        uint4 o; o.x = pack2(v0.x * g0.x, v0.y * g0.y); o.y = pack2(v0.z * g0.z, v0.w * g0.w);
        o.z = pack2(v1.x * g1.x, v1.y * g1.y); o.w = pack2(v1.z * g1.z, v1.w * g1.w);
        *reinterpret_cast<uint4*>(XG + off) = o;
      }
      __syncthreads();
    }
  }
}

#define DPP_MAX(v, ctrl) { uint32_t _t = (uint32_t)__builtin_amdgcn_update_dpp((int)(v), (int)(v), ctrl, 0xf, 0xf, false); v = (_t > v) ? _t : v; }
#define DPP_ADDF(v, ctrl) { float _t = __builtin_bit_cast(float, __builtin_amdgcn_update_dpp(__builtin_bit_cast(int, v), __builtin_bit_cast(int, v), ctrl, 0xf, 0xf, false)); v += _t; }

__device__ void phase6(const Params& p, int bid, int nb, char* smem) {
  char* ws = p.ws;
  float* Cs = reinterpret_cast<float*>(smem);
  const u16* h2 = (const u16*)(ws + OFF_XG);
  const float* rowss = (const float*)(ws + OFF_ROWSS);
  float* rstd_s = reinterpret_cast<float*>(smem + 98304);
  float* TS = (float*)(ws + OFF_TOPS);
  int* TI = (int*)(ws + OFF_TOPI);
  const int xcd = bid & 7, lb = bid >> 3, nlb = (nb + 7 - xcd) >> 3;
  for (int li = lb; li < 128; li += nlb) {
    const int tid = launder(threadIdx.x), lane = tid & 63, w = tid >> 6, wm = w >> 1, wn = w & 1, n = lane & 31, h = lane >> 5;
    int tm = 8 * xcd + (li >> 4), ct = li & 15;
    f32x16 acc[2][2];
#pragma unroll
    for (int a = 0; a < 2; ++a)
#pragma unroll
      for (int b = 0; b < 2; ++b) acc[a][b] = zero16();
    gemm_mainloop(acc, LdPlain{h2 + (size_t)tm * 256 * 1024, 1024},
                  LdPlain{(const u16*)(ws + OFF_WPQT) + (size_t)(ct * 128) * 1024, 1024}, 1024, smem, tid);
    if (tid < 256) {
      const float4 a = *reinterpret_cast<const float4*>(rowss + (size_t)(tm * 256 + tid) * 8);
      const float4 b = *reinterpret_cast<const float4*>(rowss + (size_t)(tm * 256 + tid) * 8 + 4);
      rstd_s[tid] = rsqrtf((a.x + a.y + a.z + a.w + b.x + b.y + b.z + b.w) * (1.f / 1024.f) + 1e-6f);
    }
    __syncthreads();
    {
      const u16* sk = (const u16*)(ws + OFF_SUBK) + (size_t)ct * 128 * 128;
      uint4 rb[4];
#pragma unroll
      for (int i = 0; i < 4; ++i) {
        int idx = tid + 512 * i, row = idx >> 4, c16 = idx & 15;
        rb[i] = *reinterpret_cast<const uint4*>(sk + row * 128 + c16 * 8);
      }
#pragma unroll
      for (int mi = 0; mi < 2; ++mi)
#pragma unroll
        for (int ni = 0; ni < 2; ++ni)
#pragma unroll
          for (int r = 0; r < 16; ++r) {
            int row = wm * 64 + mi * 32 + (r & 3) + 8 * (r >> 2) + 4 * h;
            int col = wn * 64 + ni * 32 + n;
            int panel = col >> 6, cc = col & 63;
            u16 bv = (u16)(pack2(acc[mi][ni][r] * rstd_s[row], 0.f) & 0xffffu);
            *reinterpret_cast<u16*>(smem + panel * 32768 + swz(row, cc >> 3) + (cc & 7) * 2) = bv;
          }
#pragma unroll
      for (int i = 0; i < 4; ++i) {
        int idx = tid + 512 * i, row = idx >> 4, c16 = idx & 15;
        *reinterpret_cast<uint4*>(smem + 65536 + (c16 >> 3) * 16384 + swz(row, c16 & 7)) = rb[i];
      }
    }
    __syncthreads();
#pragma unroll
    for (int a = 0; a < 2; ++a)
#pragma unroll
      for (int b = 0; b < 2; ++b) acc[a][b] = zero16();
#pragma unroll
    for (int pn = 0; pn < 2; ++pn)
#pragma unroll
      for (int ks = 0; ks < 4; ++ks) {
        bf16x8 af[2], bfr[2];
#pragma unroll
        for (int mi = 0; mi < 2; ++mi) af[mi] = *reinterpret_cast<const bf16x8*>(smem + pn * 32768 + swz(wm * 64 + mi * 32 + n, ks * 2 + h));
#pragma unroll
        for (int ni = 0; ni < 2; ++ni) bfr[ni] = *reinterpret_cast<const bf16x8*>(smem + 65536 + pn * 16384 + swz(wn * 64 + ni * 32 + n, ks * 2 + h));
#pragma unroll
        for (int mi = 0; mi < 2; ++mi)
#pragma unroll
          for (int ni = 0; ni < 2; ++ni) acc[mi][ni] = mfma32(af[mi], bfr[ni], acc[mi][ni]);
      }
    __syncthreads();
    stage_acc(acc, Cs, tid);
    __syncthreads();
    {
      const int q = lane >> 4, li = lane & 15;
#pragma unroll 1
      for (int grp = 0; grp < 8; grp += 2) {
        const int rowA = w * 32 + grp * 4 + q, rowB = rowA + 4;
        const float* rpA = Cs + rowA * CLD;
        const float* rpB = Cs + rowB * CLD;
        uint32_t kA[8], kB[8];
        {
          float4 v0 = *reinterpret_cast<const float4*>(rpA + li * 8), v1 = *reinterpret_cast<const float4*>(rpA + li * 8 + 4);
          float4 w0 = *reinterpret_cast<const float4*>(rpB + li * 8), w1 = *reinterpret_cast<const float4*>(rpB + li * 8 + 4);
          float va[8] = {v0.x, v0.y, v0.z, v0.w, v1.x, v1.y, v1.z, v1.w};
          float vb[8] = {w0.x, w0.y, w0.z, w0.w, w1.x, w1.y, w1.z, w1.w};
#pragma unroll
          for (int e = 0; e < 8; ++e) {
            uint32_t u = __float_as_uint(va[e]);
            u = (u & 0x80000000u) ? ~u : (u | 0x80000000u);
            kA[e] = (u & ~127u) | (uint32_t)(127 - (li * 8 + e));
            u = __float_as_uint(vb[e]);
            u = (u & 0x80000000u) ? ~u : (u | 0x80000000u);
            kB[e] = (u & ~127u) | (uint32_t)(127 - (li * 8 + e));
          }
        }
#pragma unroll
        for (int ph = 0; ph < 8; ++ph) {
#pragma unroll
          for (int e = (ph & 1); e + 1 < 8; e += 2) {
            uint32_t hi = kA[e] > kA[e + 1] ? kA[e] : kA[e + 1], lo = kA[e] > kA[e + 1] ? kA[e + 1] : kA[e];
            kA[e] = hi; kA[e + 1] = lo;
            hi = kB[e] > kB[e + 1] ? kB[e] : kB[e + 1]; lo = kB[e] > kB[e + 1] ? kB[e + 1] : kB[e];
            kB[e] = hi; kB[e + 1] = lo;
          }
        }
        uint32_t resA = 0, resB = 0;
#pragma unroll 4
        for (int itx = 0; itx < 16; ++itx) {
          uint32_t mA = kA[0], mB = kB[0];
          DPP_MAX(mA, 0xB1); DPP_MAX(mB, 0xB1);
          DPP_MAX(mA, 0x4E); DPP_MAX(mB, 0x4E);
          DPP_MAX(mA, 0x141); DPP_MAX(mB, 0x141);
          DPP_MAX(mA, 0x140); DPP_MAX(mB, 0x140);
          const bool wA = (kA[0] == mA), wB = (kB[0] == mB);
#pragma unroll
          for (int e = 0; e < 7; ++e) { kA[e] = wA ? kA[e + 1] : kA[e]; kB[e] = wB ? kB[e + 1] : kB[e]; }
          kA[7] = wA ? 0u : kA[7]; kB[7] = wB ? 0u : kB[7];
          resA = (li == itx) ? mA : resA; resB = (li == itx) ? mB : resB;
        }
        const int colA = 127 - (int)(resA & 127u), colB = 127 - (int)(resB & 127u);
        const float valA = rpA[colA], valB = rpB[colB];
        const size_t oA = ((size_t)(tm * 256 + rowA) * 16 + ct) * 16 + li, oB = ((size_t)(tm * 256 + rowB) * 16 + ct) * 16 + li;
        TS[oA] = valA; TI[oA] = colA; TS[oB] = valB; TI[oB] = colB;
      }
    }
    __syncthreads();
  }
}

DI f32x2 cvt8(unsigned w, bool hi) { return hi ? __builtin_amdgcn_cvt_pk_f32_fp8((int)w, true) : __builtin_amdgcn_cvt_pk_f32_fp8((int)w, false); }
constexpr size_t OFF_LIDX = OFF_QKV;
constexpr size_t OFF_GATE = OFF_QKV + 8 * MB;
constexpr size_t OFF_DOTS = OFF_QKV + 16 * MB;
#define DPP_F(v, ctrl) __builtin_bit_cast(float, __builtin_amdgcn_update_dpp(0, __builtin_bit_cast(int, (v)), ctrl, 0xf, 0xf, false))

__device__ void phase7a(const Params& p, int bid, int nb, char* smem) {
  char* ws = p.ws;
  const int lane = threadIdx.x & 63, w = __builtin_amdgcn_readfirstlane(threadIdx.x >> 6);
  int* lidx = reinterpret_cast<int*>(smem) + w * 896;
  float* lw = reinterpret_cast<float*>(smem) + w * 896 + 128;
  float* lts = reinterpret_cast<float*>(smem) + w * 896 + 384;
  int* lti = reinterpret_cast<int*>(smem) + w * 896 + 640;
  const float* TS = (const float*)(ws + OFF_TOPS);
  const int* TI = (const int*)(ws + OFF_TOPI);
  int* LIDX = (int*)(ws + OFF_LIDX);
  float* GATE = (float*)(ws + OFF_GATE);
  int ca, cb;
  if (lane < 16) { ca = 0; cb = lane; } else if (lane < 24) { ca = 1; cb = lane - 16; } else if (lane < 29) { ca = 2; cb = lane - 24; }
  else if (lane < 33) { ca = 3; cb = lane - 29; } else if (lane < 36) { ca = 4; cb = lane - 33; } else if (lane < 38) { ca = 5; cb = lane - 36; }
  else if (lane < 40) { ca = 6; cb = lane - 38; } else if (lane < 42) { ca = 7; cb = lane - 40; } else if (lane < 50) { ca = lane - 34; cb = 0; }
  else { ca = 0; cb = 0; }
  const bool isc = lane < 50;
  const int tstride = nb * WPB;
  int t = bid * WPB + w;
  float4 pts; int4 pti;
  if (t < T_) { pts = *reinterpret_cast<const float4*>(TS + (size_t)t * 256 + lane * 4); pti = *reinterpret_cast<const int4*>(TI + (size_t)t * 256 + lane * 4); }
  for (; t < T_; t += tstride) {
    *reinterpret_cast<float4*>(lts + lane * 4) = pts;
    *reinterpret_cast<int4*>(lti + lane * 4) = pti;
    if (t + tstride < T_) { pts = *reinterpret_cast<const float4*>(TS + (size_t)(t + tstride) * 256 + lane * 4); pti = *reinterpret_cast<const int4*>(TI + (size_t)(t + tstride) * 256 + lane * 4); }
    __builtin_amdgcn_fence(__ATOMIC_RELEASE, "wavefront");
    __builtin_amdgcn_wave_barrier();
#pragma unroll 2
    for (int hh = 0; hh < 8; ++hh) {
      const float key = lts[hh * 32 + ca] + lts[hh * 32 + 16 + cb];
      const int eidx = lti[hh * 32 + ca] * 128 + lti[hh * 32 + 16 + cb];
      uint32_t uk = __float_as_uint(key);
      uk = (uk & 0x80000000u) ? ~uk : (uk | 0x80000000u);
      uk = isc ? ((uk & ~63u) | (uint32_t)(63 - lane)) : 0u;
      int rank = 0;
#pragma unroll
      for (int j = 0; j < 50; ++j) {
        const uint32_t kj = (uint32_t)__builtin_amdgcn_readlane((int)uk, j);
        rank += (kj > uk) ? 1 : 0;
      }
      const bool sel = isc && rank < 16;
      const float mx = __builtin_bit_cast(float, __builtin_amdgcn_readlane(__builtin_bit_cast(int, key), 0));
      if (sel) { lidx[hh * 16 + rank] = eidx; lw[hh * 16 + rank] = __expf(key - mx); }
    }
    __builtin_amdgcn_fence(__ATOMIC_RELEASE, "wavefront");
    __builtin_amdgcn_wave_barrier();
    LIDX[(size_t)t * 128 + lane] = lidx[lane]; LIDX[(size_t)t * 128 + 64 + lane] = lidx[lane + 64];
    GATE[(size_t)t * 128 + lane] = lw[lane]; GATE[(size_t)t * 128 + 64 + lane] = lw[lane + 64];
    __builtin_amdgcn_fence(__ATOMIC_RELEASE, "wavefront");
    __builtin_amdgcn_wave_barrier();
  }
}

constexpr size_t OFF_PD = OFF_QKV + 16 * MB;
constexpr size_t OFF_WFIN = OFF_QKV + 80 * MB;
__device__ void phase7b(const Params& p, int bid, int nb, char* smem) {
  char* ws = p.ws;
  const int lane = threadIdx.x & 63, w = __builtin_amdgcn_readfirstlane(threadIdx.x >> 6);
  int* lidx0 = reinterpret_cast<int*>(smem) + w * 256;
  int* lidx1 = lidx0 + 128;
  const u16* XG = (const u16*)(ws + OFF_XG);
  const int* LIDX = (const int*)(ws + OFF_LIDX);
  const int xs = bid & 7;
  const unsigned char* U8 = (const unsigned char*)(ws + OFF_U8) + (size_t)xs * (16384 * 128);
  float* PD = (float*)(ws + OFF_PD) + (size_t)xs * T_ * 128;
  const int lwv = (bid >> 3) * WPB + w, nwv = ((nb + 7 - xs) >> 3) * WPB;
  const int j = lane >> 3, c = lane & 7;
  const bool c2 = (c & 4) != 0, c1 = (c & 2) != 0, c0 = (c & 1) != 0;
  const int itb = (c2 ? 8 : 0) + (c1 ? 4 : 0) + (c0 ? 2 : 0);
  const uint32_t coff = (uint32_t)(xs * 128 + c * 16);
  int pe0 = 0, pe1 = 0; uint4 pxa = make_uint4(0, 0, 0, 0), pxb = make_uint4(0, 0, 0, 0);
#define P7B_PREFETCH(tt) { pe0 = LIDX[(size_t)(tt) * 128 + lane]; pe1 = LIDX[(size_t)(tt) * 128 + 64 + lane]; \
    pxa = *reinterpret_cast<const uint4*>(XG + (size_t)(tt) * 1024 + coff); pxb = *reinterpret_cast<const uint4*>(XG + (size_t)(tt) * 1024 + coff + 8); }
#define P7B_STAGE(LB, BUF, HX, tt) { \
    LB[lane] = pe0; LB[lane + 64] = pe1; \
    HX[0] = f32x2{bf_lo(pxa.x), bf_hi(pxa.x)}; HX[1] = f32x2{bf_lo(pxa.y), bf_hi(pxa.y)}; HX[2] = f32x2{bf_lo(pxa.z), bf_hi(pxa.z)}; HX[3] = f32x2{bf_lo(pxa.w), bf_hi(pxa.w)}; \
    HX[4] = f32x2{bf_lo(pxb.x), bf_hi(pxb.x)}; HX[5] = f32x2{bf_lo(pxb.y), bf_hi(pxb.y)}; HX[6] = f32x2{bf_lo(pxb.z), bf_hi(pxb.z)}; HX[7] = f32x2{bf_lo(pxb.w), bf_hi(pxb.w)}; \
    if ((tt) + nwv < T_) P7B_PREFETCH((tt) + nwv) \
    __builtin_amdgcn_fence(__ATOMIC_RELEASE, "wavefront"); __builtin_amdgcn_wave_barrier(); \
    _Pragma("unroll") for (int it = 0; it < 16; ++it) { const int e_ = LB[it * 8 + j]; BUF[it] = *reinterpret_cast<const uint4*>(U8 + (uint32_t)(e_ * 128 + c * 16)); } }
#define P7B_COMP(BUF, HX, tt) { \
    float d_[16]; \
    _Pragma("unroll") for (int it = 0; it < 16; ++it) { \
      f32x2 d2 = cvt8(BUF[it].x, false) * HX[0]; \
      d2 += cvt8(BUF[it].x, true) * HX[1]; d2 += cvt8(BUF[it].y, false) * HX[2]; d2 += cvt8(BUF[it].y, true) * HX[3]; \
      d2 += cvt8(BUF[it].z, false) * HX[4]; d2 += cvt8(BUF[it].z, true) * HX[5]; d2 += cvt8(BUF[it].w, false) * HX[6]; d2 += cvt8(BUF[it].w, true) * HX[7]; \
      d_[it] = d2.x + d2.y; } \
    float e_[8]; \
    _Pragma("unroll") for (int i = 0; i < 8; ++i) { float mine = c2 ? d_[i + 8] : d_[i], snd = c2 ? d_[i] : d_[i + 8]; e_[i] = mine + DPP_F(snd, 0x141); } \
    float f_[4]; \
    _Pragma("unroll") for (int i = 0; i < 4; ++i) { float mine = c1 ? e_[i + 4] : e_[i], snd = c1 ? e_[i] : e_[i + 4]; f_[i] = mine + DPP_F(snd, 0x4E); } \
    float g_[2]; \
    _Pragma("unroll") for (int i = 0; i < 2; ++i) { float mine = c0 ? f_[i + 2] : f_[i], snd = c0 ? f_[i] : f_[i + 2]; g_[i] = mine + DPP_F(snd, 0xB1); } \
    PD[(size_t)(tt) * 128 + itb * 8 + j] = g_[0]; PD[(size_t)(tt) * 128 + (itb + 1) * 8 + j] = g_[1]; }
  int t = lwv;
  uint4 bA[16], bB[16];
  f32x2 hA[8], hB[8];
  if (t < T_) { P7B_PREFETCH(t) P7B_STAGE(lidx0, bA, hA, t) }
  for (; t < T_; t += 2 * nwv) {
    const int t1 = t + nwv, t2 = t + 2 * nwv;
    if (t1 < T_) P7B_STAGE(lidx1, bB, hB, t1)
    P7B_COMP(bA, hA, t)
    if (t1 < T_) {
      if (t2 < T_) P7B_STAGE(lidx0, bA, hA, t2)
      P7B_COMP(bB, hB, t1)
    }
  }
}

__device__ void phase7b2(const Params& p, int bid, int nb) {
  char* ws = p.ws;
  const int lane = threadIdx.x & 63, w = __builtin_amdgcn_readfirstlane(threadIdx.x >> 6);
  const float* USC = (const float*)(ws + OFF_USC);
  const float* rowss = (const float*)(ws + OFF_ROWSS);
  const int* LIDX = (const int*)(ws + OFF_LIDX);
  const float* GATE = (const float*)(ws + OFF_GATE);
  const float* PD = (const float*)(ws + OFF_PD);
  float* WF = (float*)(ws + OFF_WFIN);
  for (int t = bid * WPB + w; t < T_; t += nb * WPB) {
    const int e0 = LIDX[(size_t)t * 128 + lane], e1 = LIDX[(size_t)t * 128 + 64 + lane];
    const float g0 = GATE[(size_t)t * 128 + lane], g1 = GATE[(size_t)t * 128 + 64 + lane];
    float d0 = 0.f, d1 = 0.f;
#pragma unroll
    for (int x = 0; x < 8; ++x) { d0 += PD[((size_t)x * T_ + t) * 128 + lane]; d1 += PD[((size_t)x * T_ + t) * 128 + 64 + lane]; }
    const float pss = (lane < 8) ? rowss[(size_t)t * 8 + lane] : 0.f;
    const float rstd = rsqrtf(wave_sum(pss) * (1.f / 1024.f) + 1e-6f);
    const float2 sc0 = *reinterpret_cast<const float2*>(USC + (size_t)e0 * 2);
    const float2 sc1 = *reinterpret_cast<const float2*>(USC + (size_t)e1 * 2);
    const float da = d0 * rstd * sc0.x, db = d1 * rstd * sc1.x;
    const float acta = 0.5f * da * (1.f + erff(da * 0.70710678118654752f));
    const float actb = 0.5f * db * (1.f + erff(db * 0.70710678118654752f));
    float sa = g0, sb = g1;
    DPP_ADDF(sa, 0xB1); DPP_ADDF(sa, 0x4E); DPP_ADDF(sa, 0x141); DPP_ADDF(sa, 0x140);
    DPP_ADDF(sb, 0xB1); DPP_ADDF(sb, 0x4E); DPP_ADDF(sb, 0x141); DPP_ADDF(sb, 0x140);
    WF[(size_t)t * 128 + lane] = (g0 / sa) * acta * sc0.y;
    WF[(size_t)t * 128 + 64 + lane] = (g1 / sb) * actb * sc1.y;
  }
}

__device__ void phase7c(const Params& p, int bid, int nb, char* smem, float* dstbase) {
  char* ws = p.ws;
  const int lane = threadIdx.x & 63, w = __builtin_amdgcn_readfirstlane(threadIdx.x >> 6);
  int* lidx0 = reinterpret_cast<int*>(smem) + w * 1536;
  int* lidx1 = lidx0 + 128;
  float* lw0 = reinterpret_cast<float*>(smem) + w * 1536 + 256;
  float* lw1 = lw0 + 128;
  float* red = reinterpret_cast<float*>(smem) + w * 1536 + 512;
  const int* LIDX = (const int*)(ws + OFF_LIDX);
  const float* WF = (const float*)(ws + OFF_WFIN);
  const int xs = bid & 7;
  const unsigned char* V8 = (const unsigned char*)(ws + OFF_V8) + (size_t)xs * (16384 * 128);
  const int lwv = (bid >> 3) * WPB + w, nwv = ((nb + 7 - xs) >> 3) * WPB;
  const int j = lane >> 3, c = lane & 7;
  const uint32_t coff = (uint32_t)(xs * 128 + c * 16);
  int pe0 = 0, pe1 = 0; float pw0 = 0.f, pw1 = 0.f;
#define P7C_PREFETCH(tt) { pe0 = LIDX[(size_t)(tt) * 128 + lane]; pe1 = LIDX[(size_t)(tt) * 128 + 64 + lane]; \
    pw0 = WF[(size_t)(tt) * 128 + lane]; pw1 = WF[(size_t)(tt) * 128 + 64 + lane]; }
#define P7C_STAGE(LB, LWB, BUF, tt) { \
    LB[lane] = pe0; LB[lane + 64] = pe1; LWB[lane] = pw0; LWB[lane + 64] = pw1; \
    if ((tt) + nwv < T_) P7C_PREFETCH((tt) + nwv) \
    __builtin_amdgcn_fence(__ATOMIC_RELEASE, "wavefront"); __builtin_amdgcn_wave_barrier(); \
    _Pragma("unroll") for (int it = 0; it < 16; ++it) { const int e_ = LB[it * 8 + j]; BUF[it] = *reinterpret_cast<const uint4*>(V8 + (uint32_t)(e_ * 128 + c * 16)); } }
#define P7C_COMP(LWB, BUF, tt) { \
    f32x2 acc[8]; \
    _Pragma("unroll") for (int q = 0; q < 8; ++q) acc[q] = f32x2{0.f, 0.f}; \
    _Pragma("unroll") for (int it = 0; it < 16; ++it) { \
      const float wk_ = LWB[it * 8 + j]; const f32x2 w2 = f32x2{wk_, wk_}; \
      acc[0] += w2 * cvt8(BUF[it].x, false); acc[1] += w2 * cvt8(BUF[it].x, true); \
      acc[2] += w2 * cvt8(BUF[it].y, false); acc[3] += w2 * cvt8(BUF[it].y, true); \
      acc[4] += w2 * cvt8(BUF[it].z, false); acc[5] += w2 * cvt8(BUF[it].z, true); \
      acc[6] += w2 * cvt8(BUF[it].w, false); acc[7] += w2 * cvt8(BUF[it].w, true); } \
    _Pragma("unroll") for (int q = 0; q < 4; ++q) \
      *reinterpret_cast<float4*>(red + j * 128 + c * 16 + q * 4) = make_float4(acc[2 * q].x, acc[2 * q].y, acc[2 * q + 1].x, acc[2 * q + 1].y); \
    __builtin_amdgcn_fence(__ATOMIC_RELEASE, "wavefront"); __builtin_amdgcn_wave_barrier(); \
    float2 sum = *reinterpret_cast<const float2*>(red + 2 * lane); \
    _Pragma("unroll") for (int jj = 1; jj < 8; ++jj) { float2 v = *reinterpret_cast<const float2*>(red + jj * 128 + 2 * lane); sum.x += v.x; sum.y += v.y; } \
    const size_t o = (size_t)(tt) * 1024 + xs * 128 + 2 * lane; \
    float2 x0 = *reinterpret_cast<const float2*>(p.out + o); \
    x0.x += sum.x; x0.y += sum.y; \
    *reinterpret_cast<float2*>(dstbase + o) = x0; \
    __builtin_amdgcn_fence(__ATOMIC_RELEASE, "wavefront"); __builtin_amdgcn_wave_barrier(); }
  int t = lwv;
  uint4 bA[16], bB[16];
  if (t < T_) { P7C_PREFETCH(t) P7C_STAGE(lidx0, lw0, bA, t) }
  for (; t < T_; t += 2 * nwv) {
    const int t1 = t + nwv, t2 = t + 2 * nwv;
    if (t1 < T_) P7C_STAGE(lidx1, lw1, bB, t1)
    P7C_COMP(lw0, bA, t)
    if (t1 < T_) {
      if (t2 < T_) P7C_STAGE(lidx0, lw0, bA, t2)
      P7C_COMP(lw1, bB, t1)
    }
  }
}

#define XB_TMO      128
#define XB_XCNT(j)  (256  + 64 * (j))
#define XB_XSUB(j)  (1280 + 64 * (j))
#define XB_XGEN(j)  (2304 + 64 * (j))
#define XB_TOP      3328
#define XB_TOPGEN   3392
#define XCD_BAR_WORDS 3456
#define XB_SPIN_CAP (1u << 20)
#define LAS __attribute__((address_space(3)))
DI unsigned xb_ld(unsigned* p)              { return __hip_atomic_load(p, __ATOMIC_RELAXED, __HIP_MEMORY_SCOPE_AGENT); }
DI unsigned xb_add(unsigned* p, unsigned v) { return __hip_atomic_fetch_add(p, v, __ATOMIC_RELAXED, __HIP_MEMORY_SCOPE_AGENT); }
DI unsigned xb_xcc_id() { return (unsigned)__builtin_amdgcn_s_getreg((3 << 11) | 20) & 0xFu; }
#define XB_SPIN(cond, bar) do { unsigned _sp = 0; while (cond) { __builtin_amdgcn_s_sleep(1); \
    if ((++_sp & 255u) == 0u) { if (xb_ld(&(bar)[XB_TMO])) break; if (_sp > XB_SPIN_CAP) { atomicAdd(&(bar)[XB_TMO], 1u); break; } } } } while (0)
struct XcdBarrier { unsigned* bar; unsigned x; volatile LAS unsigned* st; };
DI XcdBarrier xcd_barrier_post(unsigned* bar, volatile LAS unsigned* st) {
  XcdBarrier b; b.bar = bar; b.x = xb_xcc_id(); b.st = st;
  if (threadIdx.x == 0) (void)xb_add(&bar[XB_XCNT(b.x)], 1u);
  return b;
}
DI void xcd_barrier_complete(unsigned* bar, unsigned x, unsigned& nloc, unsigned& nx) {
  const unsigned G = gridDim.x * gridDim.y * gridDim.z;
  unsigned sum, cnt, mine, sp = 0u;
  for (;;) {
    sum = 0u; cnt = 0u; mine = 0u;
#pragma unroll
    for (unsigned j = 0; j < 16; ++j) { const unsigned c = xb_ld(&bar[XB_XCNT(j)]); sum += c; cnt += (c > 0u) ? 1u : 0u; mine = (j == x) ? c : mine; }
    if (sum == G) break;
    __builtin_amdgcn_s_sleep(1);
    if ((++sp & 255u) == 0u) { if (xb_ld(&bar[XB_TMO])) break; if (sp > XB_SPIN_CAP) { atomicAdd(&bar[XB_TMO], 1u); break; } }
  }
  nloc = mine > 0u ? mine : 1u; nx = cnt > 0u ? cnt : 1u;
}
DI void xcd_barrier(const XcdBarrier& b, const Params* fp = nullptr, int fill = -1, int bid = 0, int nb = 1) {
  asm volatile("s_waitcnt vmcnt(0)" ::: "memory");
  __syncthreads();
  if (fill >= 0 && threadIdx.x >= 64) {
    const int wv = __builtin_amdgcn_readfirstlane(threadIdx.x >> 6);
    const int slot = fill * 7 + (wv - 1);
    float* usc = (float*)(fp->ws + OFF_USC);
#pragma unroll 1
    for (int j = 0; j < 2; ++j) {
      const int r = (slot * nb + bid) * 2 + j;
      if (r < 16384)
        fp8_row2(fp->peer_u + (size_t)r * 1024, (unsigned char*)(fp->ws + OFF_U8) + (size_t)r * 128, usc + r * 2,
                 fp->peer_v + (size_t)r * 1024, (unsigned char*)(fp->ws + OFF_V8) + (size_t)r * 128, usc + r * 2 + 1);
    }
  }
  if (threadIdx.x == 0) {
    unsigned* bar = b.bar;
    __builtin_amdgcn_s_waitcnt(0);
    unsigned nloc = b.st[0], nx = b.st[1];
    if (nloc == 0u) { xcd_barrier_complete(bar, b.x, nloc, nx); b.st[0] = nloc; b.st[1] = nx; }
    const unsigned old = xb_add(&bar[XB_XSUB(b.x)], 1u);
    const unsigned gen = old / nloc;
    if (old + 1u == (gen + 1u) * nloc) {
      __builtin_amdgcn_fence(__ATOMIC_RELEASE, "agent");
      asm volatile("s_waitcnt vmcnt(0)" ::: "memory");
      const unsigned og = xb_add(&bar[XB_TOP], 1u);
      const unsigned tg = og / nx;
      if (og + 1u == (tg + 1u) * nx) xb_add(&bar[XB_TOPGEN], 1u);
      else XB_SPIN(xb_ld(&bar[XB_TOPGEN]) == tg, bar);
      __builtin_amdgcn_fence(__ATOMIC_ACQUIRE, "agent");
      xb_add(&bar[XB_XGEN(b.x)], 1u);
      asm volatile("s_waitcnt vmcnt(0)" ::: "memory");
    } else {
      XB_SPIN(xb_ld(&bar[XB_XGEN(b.x)]) == gen, bar);
      __builtin_amdgcn_fence(__ATOMIC_ACQUIRE, "agent");
      asm volatile("s_waitcnt vmcnt(0)" ::: "memory");
    }
  }
  __syncthreads();
}

constexpr int SMEM_BYTES = 3 * STAGE_BYTES;

#if MK_FUSED
__global__ void __launch_bounds__(NTHR, 2) mega_kernel(Params p) {
  __shared__ __attribute__((aligned(16))) char smem[SMEM_BYTES];
  cg::grid_group grid = cg::this_grid();
  __shared__ uint4 xb_words;
  if (threadIdx.x == 0) xb_words = make_uint4(0u, 0u, 0u, 0u);
  __syncthreads();
  (void)xcd_barrier_post((unsigned*)(p.ws + OFF_BAR), (volatile LAS unsigned*)&xb_words);
  const int bid = blockIdx.x, nb = gridDim.x;
#define XBAR() { XcdBarrier xb_; xb_.bar = (unsigned*)(p.ws + OFF_BAR); xb_.x = xb_xcc_id(); xb_.st = (volatile LAS unsigned*)&xb_words; xcd_barrier(xb_); }
#define RUNP(ph, call) { int nrep_ = launder_s((PROBE_DUP & (1 << ph)) ? 2 : 1); _Pragma("unroll 1") for (int rep_ = 0; rep_ < nrep_; ++rep_) { call; XBAR() } }
#define XBARF(bi) { XcdBarrier xb_; xb_.bar = (unsigned*)(p.ws + OFF_BAR); xb_.x = xb_xcc_id(); xb_.st = (volatile LAS unsigned*)&xb_words; \
                    xcd_barrier(xb_, &p, (nb * 70 >= 16384) ? (bi) : -1, bid, nb); }
  phase0(p, bid, nb, smem); XBARF(0)
  phase1(p, bid, nb, smem); XBARF(1)
  phase2(p, bid, nb, smem); XBARF(2)
  phase2b(p, bid, nb); XBARF(3)
  phase3(p, bid, nb, smem); XBARF(4)
  RUNP(5, phase4(p, bid, nb, smem))
  RUNP(7, phase6(p, bid, nb, smem))
  phase7a(p, bid, nb, smem); XBAR()
  phase7b(p, bid, nb, smem); XBAR()
  phase7b2(p, bid, nb); XBAR()
  phase7c(p, bid, nb, smem, p.out);
  if (p.ws == nullptr) grid.sync();
}
#else
#define PHASE_KERNEL(name, call) \
  __global__ void __launch_bounds__(NTHR, 2) name(Params p) { \
    __shared__ __attribute__((aligned(16))) char smem[SMEM_BYTES]; \
    const int bid = blockIdx.x, nb = gridDim.x; (void)smem; call; }
PHASE_KERNEL(k_p0, phase0(p, bid, nb, smem))
PHASE_KERNEL(k_p1, phase1(p, bid, nb, smem))
PHASE_KERNEL(k_p2, phase2(p, bid, nb, smem))
PHASE_KERNEL(k_p2b, phase2b(p, bid, nb))
PHASE_KERNEL(k_p3, phase3(p, bid, nb, smem))
PHASE_KERNEL(k_p4, phase4(p, bid, nb, smem))
PHASE_KERNEL(k_p6, phase6(p, bid, nb, smem))
PHASE_KERNEL(k_p7a, phase7a(p, bid, nb, smem))
PHASE_KERNEL(k_p7b, phase7b(p, bid, nb, smem))
PHASE_KERNEL(k_p7b2, phase7b2(p, bid, nb))
PHASE_KERNEL(k_p7c, phase7c(p, bid, nb, smem, p.out))
#endif

extern "C" void kernel_launch(void* const* d_in, const int* in_sizes, int n_in, void* d_out, int out_size, void* d_ws,
                              size_t ws_size, hipStream_t stream) {
  Params p{};
  p.x = (const float*)d_in[0]; p.mem = (const float*)d_in[1]; p.g_mix = (const float*)d_in[2]; p.g_mem = (const float*)d_in[3];
  p.w_in = (const float*)d_in[4]; p.w_mem_kv = (const float*)d_in[5]; p.g_q_dil = (const float*)d_in[6]; p.g_k_dil = (const float*)d_in[7];
  p.g_q_mem = (const float*)d_in[8]; p.g_k_mem = (const float*)d_in[9]; p.w_o_sb = (const float*)d_in[10]; p.w_o_dil = (const float*)d_in[11];
  p.w_o_mem = (const float*)d_in[12]; p.w_gate = (const float*)d_in[13]; p.b_gate = (const float*)d_in[14]; p.w_out = (const float*)d_in[15];
  p.g_ffn = (const float*)d_in[16]; p.w_peer_q = (const float*)d_in[17]; p.subkeys = (const float*)d_in[18]; p.peer_u = (const float*)d_in[19];
  p.peer_v = (const float*)d_in[20];
  p.out = (float*)d_out; p.ws = (char*)d_ws;
#if MK_FUSED
  static int grid_blocks = 0;
  if (!grid_blocks) {
    int dev = 0, cus = 0, per_cu = 0;
    hipGetDevice(&dev);
    hipDeviceGetAttribute(&cus, hipDeviceAttributeMultiprocessorCount, dev);
    hipOccupancyMaxActiveBlocksPerMultiprocessor(&per_cu, mega_kernel, NTHR, 0);
    per_cu = 1;
    grid_blocks = (cus * per_cu) & ~7;
  }
  hipMemsetAsync((char*)d_ws + OFF_BAR, 0, XCD_BAR_WORDS * sizeof(unsigned), stream);
  void* args[] = {&p};
  hipError_t e = hipLaunchCooperativeKernel((void*)mega_kernel, dim3(grid_blocks), dim3(NTHR), args, 0, stream);
  if (e != hipSuccess) fprintf(stderr, "cooperative launch failed: %s (grid %d)\n", hipGetErrorString(e), grid_blocks);
#else
  const int G = 512;
  k_p0<<<G, NTHR, 0, stream>>>(p);
  k_p1<<<G, NTHR, 0, stream>>>(p);
  k_p2<<<G, NTHR, 0, stream>>>(p);
  k_p2b<<<G, NTHR, 0, stream>>>(p);
  k_p3<<<G, NTHR, 0, stream>>>(p);
  k_p4<<<G, NTHR, 0, stream>>>(p);
  k_p6<<<G, NTHR, 0, stream>>>(p);
  k_p7a<<<G, NTHR, 0, stream>>>(p);
  k_p7b<<<G, NTHR, 0, stream>>>(p);
  k_p7b2<<<G, NTHR, 0, stream>>>(p);
  k_p7c<<<G, NTHR, 0, stream>>>(p);
#endif
}
```

```cpp
#include <hip/hip_runtime.h>
#include <hip/hip_cooperative_groups.h>
#include <stdint.h>
#include <cstdio>
namespace cg = cooperative_groups;

#ifndef PROBE_DUP
#define PROBE_DUP 0
#endif
#ifndef MK_FUSED
#define MK_FUSED 1
#endif

typedef unsigned short u16;
typedef __attribute__((ext_vector_type(8))) short bf16x8;
typedef __attribute__((ext_vector_type(16))) float f32x16;
typedef __attribute__((ext_vector_type(2))) float f32x2;
typedef __attribute__((ext_vector_type(2))) __bf16 bf16x2_t;

#define DI __device__ __forceinline__
#define NTHR 512
#define WPB 8

constexpr int T_ = 16384;
constexpr size_t MB = 1048576;
constexpr size_t OFF_WINT = 0;
constexpr size_t OFF_WGT  = OFF_WINT + 4352ull * 1024 * 2;
constexpr size_t OFF_WKVT = OFF_WGT + 3072ull * 1024 * 2;
constexpr size_t OFF_WOT  = OFF_WKVT + 1024ull * 1024 * 2;
constexpr size_t OFF_WOUTT = OFF_WOT + 1024ull * 1280 * 2;
constexpr size_t OFF_WPQT = OFF_WOUTT + 1024ull * 1024 * 2;
constexpr size_t OFF_SUBK = OFF_WPQT + 2048ull * 1024 * 2;
constexpr size_t OFF_QKV  = 26 * MB;
constexpr size_t OFF_QSB  = OFF_QKV;
constexpr size_t OFF_KSB  = OFF_QSB + 16 * MB;
constexpr size_t OFF_VTSB = OFF_KSB + 16 * MB;
constexpr size_t OFF_QD   = OFF_VTSB + 16 * MB;
constexpr size_t OFF_KD   = OFF_QD + 24 * MB;
constexpr size_t OFF_VTD  = OFF_KD + 24 * MB;
constexpr size_t OFF_QM   = OFF_VTD + 24 * MB;
constexpr size_t OFF_KM   = OFF_QM + 16 * MB;
constexpr size_t OFF_VTM  = OFF_KM + 2 * MB;
constexpr size_t OFF_YD   = OFF_QKV + 140 * MB;
constexpr size_t OFF_YM   = OFF_YD + 24 * MB;
constexpr size_t OFF_U8   = OFF_YM + 16 * MB;
constexpr size_t OFF_V8   = OFF_U8 + 16 * MB;
constexpr size_t OFF_USC  = OFF_V8 + 16 * MB;
constexpr size_t OFF_ROWSS = OFF_USC + 1 * MB;
constexpr size_t OFF_BAR  = OFF_ROWSS + 1 * MB;
constexpr size_t OFF_MERGED = OFF_QKV + 64 * MB;
constexpr size_t OFF_TOPS = OFF_QKV + 96 * MB;
constexpr size_t OFF_TOPI = OFF_QKV + 112 * MB;
constexpr size_t OFF_GSCR = OFF_QKV;
constexpr size_t OFF_TPARK = OFF_QKV + 16 * MB;
constexpr size_t OFF_XG   = OFF_YD;
constexpr size_t OUT_OFF_H = 0;
constexpr size_t OUT_OFF_MEMH = 32 * MB;
constexpr size_t OUT_OFF_YSB = 36 * MB;
constexpr size_t OUT_OFF_LSE = 52 * MB;
constexpr size_t OUT_OFF_YDM = 53 * MB;

struct Params {
  const float *x, *mem, *g_mix, *g_mem, *w_in, *w_mem_kv, *g_q_dil, *g_k_dil, *g_q_mem, *g_k_mem;
  const float *w_o_sb, *w_o_dil, *w_o_mem, *w_gate, *b_gate, *w_out, *g_ffn, *w_peer_q, *subkeys, *peer_u, *peer_v;
  float* out;
  char* ws;
};

DI uint32_t pack2(float a, float b) {
  f32x2 v = {a, b};
  bf16x2_t r = __builtin_convertvector(v, bf16x2_t);
  return __builtin_bit_cast(uint32_t, r);
}
DI uint4 pack8(const float* v) {
  uint4 r; r.x = pack2(v[0], v[1]); r.y = pack2(v[2], v[3]); r.z = pack2(v[4], v[5]); r.w = pack2(v[6], v[7]);
  return r;
}
DI float bf_lo(uint32_t u) { return __uint_as_float(u << 16); }
DI float bf_hi(uint32_t u) { return __uint_as_float(u & 0xffff0000u); }
DI float wave_sum(float v) {
#pragma unroll
  for (int o = 32; o; o >>= 1) v += __shfl_xor(v, o);
  return v;
}
DI f32x16 mfma32(bf16x8 a, bf16x8 b, f32x16 c) { return __builtin_amdgcn_mfma_f32_32x32x16_bf16(a, b, c, 0, 0, 0); }
DI bf16x8 ld16(const u16* p) { return *reinterpret_cast<const bf16x8*>(p); }
DI bf16x8 as_bf16x8(uint4 v) { return __builtin_bit_cast(bf16x8, v); }
DI f32x16 zero16() { f32x16 z; for (int i = 0; i < 16; ++i) z[i] = 0.f; return z; }
DI int launder(int v) { asm volatile("" : "+v"(v)); return v; }
DI char* uniform_ptr(char* p) {
  uint64_t v = (uint64_t)p;
  uint32_t lo = __builtin_amdgcn_readfirstlane((uint32_t)v), hi = __builtin_amdgcn_readfirstlane((uint32_t)(v >> 32));
  return (char*)(((uint64_t)hi << 32) | lo);
}
DI int launder_s(int v) { asm volatile("" : "+s"(v)); return v; }
DI int pi32(int i) { return (i & ~12) | ((i & 4) << 1) | ((i & 8) >> 1); }

struct LdPlain {
  const u16* p; int ld;
  DI const u16* operator()(int row, int k) const { return p + (uint32_t)(row * ld + k); }
};
DI int swz(int row, int ch) { return row * 128 + ((ch ^ ((row >> 1) & 7)) << 4); }
typedef __attribute__((address_space(3))) void lds_void;
DI void glds16(const u16* g, char* l) {
  __builtin_amdgcn_global_load_lds((const void*)g, (lds_void*)l, 16, 0, 0);
}
constexpr int STAGE_BYTES = 49152;
template <class LA, class LB>
DI void gemm_issue(const LA& la, const LB& lb, int k0, char* buf, uint32_t offA, uint32_t offB, int tid) {
#pragma unroll
  for (int i = 0; i < 4; ++i) {
    const u16* pa = la.p + (k0 + 64 * i * la.ld);
    glds16(pa + offA, buf + (tid + 512 * i) * 16);
  }
#pragma unroll
  for (int i = 0; i < 2; ++i) {
    const u16* pb = lb.p + (k0 + 64 * i * lb.ld);
    glds16(pb + offB, buf + 32768 + (tid + 512 * i) * 16);
  }
}
template <int OFF>
DI void lds_rd128(bf16x8& dst, uint32_t addr) {
  asm volatile("ds_read_b128 %0, %1 offset:%2" : "=v"(dst) : "v"(addr), "n"(OFF) : "memory");
}
#define LGKM_WAIT(N, a, b, c, d) asm volatile("s_waitcnt lgkmcnt(" #N ")" : "+v"(a), "+v"(b), "+v"(c), "+v"(d) :: "memory")
template <class LA, class LB>
DI void gemm_mainloop(f32x16 (&acc)[2][2], const LA& la, const LB& lb, int K, char* smem, int tid) {
  const int lane = tid & 63, w = tid >> 6, wm = w >> 1, wn = w & 1;
  const int n = lane & 31, h = lane >> 5;
  const int nk = K >> 6;
  const int row0 = tid >> 3, ch0 = (tid & 7) ^ ((row0 >> 1) & 7);
  const uint32_t offA = (uint32_t)(row0 * la.ld + ch0 * 8), offB = (uint32_t)(row0 * lb.ld + ch0 * 8);
  const uint32_t sbase = (uint32_t)(size_t)smem;
  const uint32_t fa0 = (uint32_t)swz(wm * 64 + n, h), fb0 = (uint32_t)swz(wn * 64 + n, h);
  gemm_issue(la, lb, 0, smem, offA, offB, tid);
  if (nk > 1) { gemm_issue(la, lb, 64, smem + STAGE_BYTES, offA, offB, tid); asm volatile("s_waitcnt vmcnt(6)" ::: "memory"); }
  else asm volatile("s_waitcnt vmcnt(0)" ::: "memory");
  __builtin_amdgcn_s_barrier();
  asm volatile("" ::: "memory");
  if (nk > 2) gemm_issue(la, lb, 128, smem + 2 * STAGE_BYTES, offA, offB, tid);
  bf16x8 af[2][2], bfr[2][2];
  lds_rd128<0>(af[0][0], sbase + fa0); lds_rd128<4096>(af[0][1], sbase + fa0);
  lds_rd128<32768>(bfr[0][0], sbase + fb0); lds_rd128<36864>(bfr[0][1], sbase + fb0);
  int st = 0;
#pragma unroll 1
  for (int kt = 0; kt < nk; ++kt) {
    const uint32_t sb_ = sbase + (uint32_t)(st * STAGE_BYTES);
    const int st1 = (st == 2) ? 0 : st + 1;
#pragma unroll
    for (int ks = 0; ks < 3; ++ks) {
      const int cur = ks & 1, nxt = cur ^ 1;
      const uint32_t aa = sb_ + (fa0 ^ (uint32_t)((ks + 1) << 5)), ab = sb_ + (fb0 ^ (uint32_t)((ks + 1) << 5));
      lds_rd128<0>(af[nxt][0], aa); lds_rd128<4096>(af[nxt][1], aa);
      lds_rd128<32768>(bfr[nxt][0], ab); lds_rd128<36864>(bfr[nxt][1], ab);
      LGKM_WAIT(4, af[cur][0], af[cur][1], bfr[cur][0], bfr[cur][1]);
#pragma unroll
      for (int mi = 0; mi < 2; ++mi)
#pragma unroll
        for (int ni = 0; ni < 2; ++ni) acc[mi][ni] = mfma32(af[cur][mi], bfr[cur][ni], acc[mi][ni]);
    }
    LGKM_WAIT(0, af[1][0], af[1][1], bfr[1][0], bfr[1][1]);
    if (kt + 1 < nk) {
      if (kt + 2 < nk) asm volatile("s_waitcnt vmcnt(6)" ::: "memory");
      else asm volatile("s_waitcnt vmcnt(0)" ::: "memory");
      __builtin_amdgcn_s_barrier();
      asm volatile("" ::: "memory");
      if (kt + 3 < nk) gemm_issue(la, lb, (kt + 3) * 64, smem + st * STAGE_BYTES, offA, offB, tid);
      const uint32_t sn = sbase + (uint32_t)(st1 * STAGE_BYTES);
      lds_rd128<0>(af[0][0], sn + fa0); lds_rd128<4096>(af[0][1], sn + fa0);
      lds_rd128<32768>(bfr[0][0], sn + fb0); lds_rd128<36864>(bfr[0][1], sn + fb0);
    }
#pragma unroll
    for (int mi = 0; mi < 2; ++mi)
#pragma unroll
      for (int ni = 0; ni < 2; ++ni) acc[mi][ni] = mfma32(af[1][mi], bfr[1][ni], acc[mi][ni]);
    st = st1;
  }
  __syncthreads();
}

constexpr int STAGE8_BYTES = 65536;
template <class LA, class LB>
DI void gemm_issue8(const LA& la, const LB& lb, int k0, char* buf, uint32_t offA, uint32_t offB, int tid) {
#pragma unroll
  for (int i = 0; i < 4; ++i) {
    const u16* pa = la.p + (k0 + 64 * i * la.ld);
    glds16(pa + offA, buf + (tid + 512 * i) * 16);
  }
#pragma unroll
  for (int i = 0; i < 4; ++i) {
    const u16* pb = lb.p + (k0 + 64 * i * lb.ld);
    glds16(pb + offB, buf + 32768 + (tid + 512 * i) * 16);
  }
}
#define LGKM_WAIT3(N, a, b, c) asm volatile("s_waitcnt lgkmcnt(" #N ")" : "+v"(a), "+v"(b), "+v"(c) :: "memory")
#define LGKM_WAIT1(N, a) asm volatile("s_waitcnt lgkmcnt(" #N ")" : "+v"(a) :: "memory")
template <class LA, class LB>
DI void gemm_mainloop8(f32x16 (&acc)[4][2], const LA& la, const LB& lb, int K, char* smem, int tid) {
  const int lane = tid & 63, w = tid >> 6, wm = w >> 2, wn = w & 3;
  const int n = lane & 31, h = lane >> 5;
  const int nk = K >> 6;
  const int row0 = tid >> 3, ch0 = (tid & 7) ^ ((row0 >> 1) & 7);
  const uint32_t offA = (uint32_t)(row0 * la.ld + ch0 * 8), offB = (uint32_t)(row0 * lb.ld + ch0 * 8);
  const uint32_t sbase = (uint32_t)(size_t)smem;
  const uint32_t fa0 = (uint32_t)swz(wm * 128 + n, h), fb0 = (uint32_t)swz(wn * 64 + n, h);
  gemm_issue8(la, lb, 0, smem, offA, offB, tid);
  asm volatile("s_waitcnt vmcnt(0)" ::: "memory");
  __builtin_amdgcn_s_barrier();
  asm volatile("" ::: "memory");
  if (nk > 1) gemm_issue8(la, lb, 64, smem + STAGE8_BYTES, offA, offB, tid);
  bf16x8 af[4], bfr[2][2];
  lds_rd128<32768>(bfr[0][0], sbase + fb0); lds_rd128<36864>(bfr[0][1], sbase + fb0);
  lds_rd128<0>(af[0], sbase + fa0); lds_rd128<4096>(af[1], sbase + fa0); lds_rd128<8192>(af[2], sbase + fa0); lds_rd128<12288>(af[3], sbase + fa0);
#pragma unroll 1
  for (int kt = 0; kt < nk; ++kt) {
    const uint32_t sb_ = sbase + (uint32_t)((kt & 1) * STAGE8_BYTES);
#pragma unroll
    for (int ks = 0; ks < 3; ++ks) {
      const int cur = ks & 1, nxt = cur ^ 1;
      const uint32_t aa = sb_ + (fa0 ^ (uint32_t)((ks + 1) << 5)), ab = sb_ + (fb0 ^ (uint32_t)((ks + 1) << 5));
      lds_rd128<32768>(bfr[nxt][0], ab); lds_rd128<36864>(bfr[nxt][1], ab);
      LGKM_WAIT3(5, af[0], bfr[cur][0], bfr[cur][1]);
      acc[0][0] = mfma32(af[0], bfr[cur][0], acc[0][0]); acc[0][1] = mfma32(af[0], bfr[cur][1], acc[0][1]);
      lds_rd128<0>(af[0], aa);
      LGKM_WAIT1(5, af[1]);
      acc[1][0] = mfma32(af[1], bfr[cur][0], acc[1][0]); acc[1][1] = mfma32(af[1], bfr[cur][1], acc[1][1]);
      lds_rd128<4096>(af[1], aa);
      LGKM_WAIT1(5, af[2]);
      acc[2][0] = mfma32(af[2], bfr[cur][0], acc[2][0]); acc[2][1] = mfma32(af[2], bfr[cur][1], acc[2][1]);
      lds_rd128<8192>(af[2], aa);
      LGKM_WAIT1(5, af[3]);
      acc[3][0] = mfma32(af[3], bfr[cur][0], acc[3][0]); acc[3][1] = mfma32(af[3], bfr[cur][1], acc[3][1]);
      lds_rd128<12288>(af[3], aa);
    }
    asm volatile("s_waitcnt lgkmcnt(0)" : "+v"(af[0]), "+v"(af[1]), "+v"(af[2]), "+v"(af[3]), "+v"(bfr[1][0]), "+v"(bfr[1][1]) :: "memory");
    const bool more = (kt + 1 < nk);
    const uint32_t sn = sbase + (uint32_t)(((kt + 1) & 1) * STAGE8_BYTES);
    if (more) {
      asm volatile("s_waitcnt vmcnt(0)" ::: "memory");
      __builtin_amdgcn_s_barrier();
      asm volatile("" ::: "memory");
      if (kt + 2 < nk) gemm_issue8(la, lb, (kt + 2) * 64, smem + (kt & 1) * STAGE8_BYTES, offA, offB, tid);
      lds_rd128<32768>(bfr[0][0], sn + fb0); lds_rd128<36864>(bfr[0][1], sn + fb0);
    }
    acc[0][0] = mfma32(af[0], bfr[1][0], acc[0][0]); acc[0][1] = mfma32(af[0], bfr[1][1], acc[0][1]);
    if (more) lds_rd128<0>(af[0], sn + fa0);
    acc[1][0] = mfma32(af[1], bfr[1][0], acc[1][0]); acc[1][1] = mfma32(af[1], bfr[1][1], acc[1][1]);
    if (more) lds_rd128<4096>(af[1], sn + fa0);
    acc[2][0] = mfma32(af[2], bfr[1][0], acc[2][0]); acc[2][1] = mfma32(af[2], bfr[1][1], acc[2][1]);
    if (more) lds_rd128<8192>(af[2], sn + fa0);
    acc[3][0] = mfma32(af[3], bfr[1][0], acc[3][0]); acc[3][1] = mfma32(af[3], bfr[1][1], acc[3][1]);
    if (more) lds_rd128<12288>(af[3], sn + fa0);
  }
  __syncthreads();
}
DI void zero_acc8(f32x16 (&acc)[4][2]) {
#pragma unroll
  for (int a = 0; a < 4; ++a)
#pragma unroll
    for (int b = 0; b < 2; ++b) acc[a][b] = zero16();
}

constexpr int CLD = 132;
DI void stage_half(const f32x16 (&acc)[4][2], float* Cs, int tid, int bj) {
  const int lane = tid & 63, w = tid >> 6, wm = w >> 2, wn = w & 3;
  const int n = lane & 31, h = lane >> 5;
  if ((wn >> 1) == bj) {
#pragma unroll
    for (int mi = 0; mi < 4; ++mi)
#pragma unroll
      for (int ni = 0; ni < 2; ++ni)
#pragma unroll
        for (int r = 0; r < 16; ++r) {
          int row = wm * 128 + mi * 32 + (r & 3) + 8 * (r >> 2) + 4 * h;
          int col = (wn & 1) * 64 + ni * 32 + n;
          Cs[row * CLD + col] = acc[mi][ni][r];
        }
  }
}
DI void stage_acc(const f32x16 (&acc)[2][2], float* Cs, int tid) {
  const int lane = tid & 63, w = tid >> 6, wm = w >> 1, wn = w & 1;
  const int n = lane & 31, h = lane >> 5;
#pragma unroll
  for (int mi = 0; mi < 2; ++mi)
#pragma unroll
    for (int ni = 0; ni < 2; ++ni)
#pragma unroll
      for (int r = 0; r < 16; ++r) {
        int row = wm * 64 + mi * 32 + (r & 3) + 8 * (r >> 2) + 4 * h;
        int col = wn * 64 + ni * 32 + n;
        Cs[row * CLD + col] = acc[mi][ni][r];
      }
}

template <int HD, bool NORM>
DI void epi_rowmajor(const float* Cs, u16* base, int H, int head0, const float* gain, float scale, int r, int SL, int tok0, int tid) {
  const int cc = tid & 15, c8 = cc * 8, hl = c8 / HD, d0 = c8 % HD;
  float g[8];
#pragma unroll
  for (int j = 0; j < 8; ++j) g[j] = NORM ? gain[d0 + j] * scale : scale;
  const int Lr = SL / r;
#pragma unroll 2
  for (int pass = 0; pass < 8; ++pass) {
    int row = (tid >> 4) + 32 * pass;
    float v[8];
    float4 v0 = *reinterpret_cast<const float4*>(Cs + row * CLD + c8);
    float4 v1 = *reinterpret_cast<const float4*>(Cs + row * CLD + c8 + 4);
    v[0] = v0.x; v[1] = v0.y; v[2] = v0.z; v[3] = v0.w; v[4] = v1.x; v[5] = v1.y; v[6] = v1.z; v[7] = v1.w;
    if (NORM) {
      float ss = 0.f;
#pragma unroll
      for (int j = 0; j < 8; ++j) ss += v[j] * v[j];
      ss += __shfl_xor(ss, 1); ss += __shfl_xor(ss, 2); ss += __shfl_xor(ss, 4);
      if (HD == 128) ss += __shfl_xor(ss, 8);
      float rstd = rsqrtf(ss * (1.f / HD) + 1e-6f);
#pragma unroll
      for (int j = 0; j < 8; ++j) v[j] *= rstd * g[j];
    } else {
#pragma unroll
      for (int j = 0; j < 8; ++j) v[j] *= g[j];
    }
    int token = tok0 + row, b = token / SL, t = token % SL;
    int pp = (t % r) * Lr + t / r;
    u16* dst = base + ((size_t)(b * H + head0 + hl) * SL + pp) * HD + d0;
    *reinterpret_cast<uint4*>(dst) = pack8(v);
  }
}
template <int HD, bool BLOCKED>
DI void epi_transposed(const float* Cs, u16* base, int H, int head0, int r, int SL, int tok0, int tid) {
  const int b = tok0 / SL, t0 = tok0 % SL, Lr = SL / r;
#pragma unroll 2
  for (int pass = 0; pass < 8; ++pass) {
    int u = tid + 512 * pass, col = u & 127, cj = u >> 7, c = cj % r, j = cj / r;
    float v[8];
#pragma unroll
    for (int e = 0; e < 8; ++e) v[e] = Cs[(c + r * (8 * j + e)) * CLD + col];
    int hl = col / HD, d = col % HD;
    int pp = c * Lr + t0 / r + 8 * j;
    u16* dst = BLOCKED ? base + ((size_t)(b * H + head0 + hl) * (SL >> 5) + (pp >> 5)) * (HD * 32) + d * 32 + (pp & 31)
                       : base + ((size_t)(b * H + head0 + hl) * HD + d) * SL + pp;
    *reinterpret_cast<uint4*>(dst) = pack8(v);
  }
}

DI void transpose_tile(const float* src, int N, u16* dst, int dst_ld, int tk, int tn, float* tile) {
  const int tid = threadIdx.x;
#pragma unroll
  for (int i = 0; i < 2; ++i) {
    int r = (tid >> 4) + 32 * i, c4 = (tid & 15) * 4;
    float4 v = *reinterpret_cast<const float4*>(src + (size_t)(tk * 64 + r) * N + tn * 64 + c4);
    tile[r * 65 + c4] = v.x; tile[r * 65 + c4 + 1] = v.y; tile[r * 65 + c4 + 2] = v.z; tile[r * 65 + c4 + 3] = v.w;
  }
  __syncthreads();
  {
    int nn = (tid >> 3), kc = (tid & 7) * 8;
    float v[8];
#pragma unroll
    for (int j = 0; j < 8; ++j) v[j] = tile[(kc + j) * 65 + nn];
    *reinterpret_cast<uint4*>(dst + (size_t)(tn * 64 + nn) * dst_ld + tk * 64 + kc) = pack8(v);
  }
  __syncthreads();
}
DI void rmsnorm_row(const float* src, const float* gain, u16* dst) {
  const int lane = threadIdx.x & 63;
  float4 v[4];
  float ss = 0.f;
#pragma unroll
  for (int i = 0; i < 4; ++i) {
    v[i] = *reinterpret_cast<const float4*>(src + i * 256 + lane * 4);
    ss += v[i].x * v[i].x + v[i].y * v[i].y + v[i].z * v[i].z + v[i].w * v[i].w;
  }
  ss = wave_sum(ss);
  float rstd = rsqrtf(ss * (1.f / 1024.f) + 1e-6f);
#pragma unroll
  for (int i = 0; i < 4; ++i) {
    float4 g = *reinterpret_cast<const float4*>(gain + i * 256 + lane * 4);
    uint2 o; o.x = pack2(v[i].x * rstd * g.x, v[i].y * rstd * g.y); o.y = pack2(v[i].z * rstd * g.z, v[i].w * rstd * g.w);
    *reinterpret_cast<uint2*>(dst + i * 256 + lane * 4) = o;
  }
}
DI void fp8_row(const float* src, unsigned char* dst, float* inv_scale) {
  const int lane = threadIdx.x & 63;
  float4 v[4];
  float am = 0.f;
#pragma unroll
  for (int i = 0; i < 4; ++i) {
    v[i] = *reinterpret_cast<const float4*>(src + lane * 16 + i * 4);
    am = fmaxf(am, fmaxf(fmaxf(fabsf(v[i].x), fabsf(v[i].y)), fmaxf(fabsf(v[i].z), fabsf(v[i].w))));
  }
#pragma unroll
  for (int o = 32; o; o >>= 1) am = fmaxf(am, __shfl_xor(am, o));
  float e = (am > 0.f) ? floorf(log2f(256.f / am)) : 0.f;
  e = fminf(fmaxf(e, -100.f), 100.f);
  const float sc = exp2f(e);
  uint4 o;
  unsigned* ow = reinterpret_cast<unsigned*>(&o);
#pragma unroll
  for (int i = 0; i < 4; ++i) {
    int w = __builtin_amdgcn_cvt_pk_fp8_f32(v[i].x * sc, v[i].y * sc, 0, false);
    w = __builtin_amdgcn_cvt_pk_fp8_f32(v[i].z * sc, v[i].w * sc, w, true);
    ow[i] = (unsigned)w;
  }
  *reinterpret_cast<uint4*>(dst + lane * 16) = o;
  if (lane == 0) *inv_scale = exp2f(-e);
}
DI void rmsnorm_row2(const float* s0, const float* g0, u16* d0, const float* s1, const float* g1, u16* d1) {
  const int lane = threadIdx.x & 63;
  float4 a[4], b[4];
#pragma unroll
  for (int i = 0; i < 4; ++i) { a[i] = *reinterpret_cast<const float4*>(s0 + i * 256 + lane * 4); b[i] = *reinterpret_cast<const float4*>(s1 + i * 256 + lane * 4); }
  float sa = 0.f, sb = 0.f;
#pragma unroll
  for (int i = 0; i < 4; ++i) {
    sa += a[i].x * a[i].x + a[i].y * a[i].y + a[i].z * a[i].z + a[i].w * a[i].w;
    sb += b[i].x * b[i].x + b[i].y * b[i].y + b[i].z * b[i].z + b[i].w * b[i].w;
  }
#pragma unroll
  for (int o = 32; o; o >>= 1) { sa += __shfl_xor(sa, o); sb += __shfl_xor(sb, o); }
  const float ra = rsqrtf(sa * (1.f / 1024.f) + 1e-6f), rb = rsqrtf(sb * (1.f / 1024.f) + 1e-6f);
#pragma unroll
  for (int i = 0; i < 4; ++i) {
    float4 ga = *reinterpret_cast<const float4*>(g0 + i * 256 + lane * 4);
    float4 gb = *reinterpret_cast<const float4*>(g1 + i * 256 + lane * 4);
    uint2 o; o.x = pack2(a[i].x * ra * ga.x, a[i].y * ra * ga.y); o.y = pack2(a[i].z * ra * ga.z, a[i].w * ra * ga.w);
    *reinterpret_cast<uint2*>(d0 + i * 256 + lane * 4) = o;
    o.x = pack2(b[i].x * rb * gb.x, b[i].y * rb * gb.y); o.y = pack2(b[i].z * rb * gb.z, b[i].w * rb * gb.w);
    *reinterpret_cast<uint2*>(d1 + i * 256 + lane * 4) = o;
  }
}
DI void fp8_row2(const float* s0, unsigned char* d0, float* i0, const float* s1, unsigned char* d1, float* i1) {
  const int lane = threadIdx.x & 63;
  float4 a[4], b[4];
#pragma unroll
  for (int i = 0; i < 4; ++i) { a[i] = *reinterpret_cast<const float4*>(s0 + lane * 16 + i * 4); b[i] = *reinterpret_cast<const float4*>(s1 + lane * 16 + i * 4); }
  float ma = 0.f, mb = 0.f;
#pragma unroll
  for (int i = 0; i < 4; ++i) {
    ma = fmaxf(ma, fmaxf(fmaxf(fabsf(a[i].x), fabsf(a[i].y)), fmaxf(fabsf(a[i].z), fabsf(a[i].w))));
    mb = fmaxf(mb, fmaxf(fmaxf(fabsf(b[i].x), fabsf(b[i].y)), fmaxf(fabsf(b[i].z), fabsf(b[i].w))));
  }
#pragma unroll
  for (int o = 32; o; o >>= 1) { ma = fmaxf(ma, __shfl_xor(ma, o)); mb = fmaxf(mb, __shfl_xor(mb, o)); }
  float ea = (ma > 0.f) ? floorf(log2f(256.f / ma)) : 0.f, eb = (mb > 0.f) ? floorf(log2f(256.f / mb)) : 0.f;
  ea = fminf(fmaxf(ea, -100.f), 100.f); eb = fminf(fmaxf(eb, -100.f), 100.f);
  const float sca = exp2f(ea), scb = exp2f(eb);
  uint4 oa, ob;
  unsigned* wa = reinterpret_cast<unsigned*>(&oa); unsigned* wb = reinterpret_cast<unsigned*>(&ob);
#pragma unroll
  for (int i = 0; i < 4; ++i) {
    int w = __builtin_amdgcn_cvt_pk_fp8_f32(a[i].x * sca, a[i].y * sca, 0, false);
    w = __builtin_amdgcn_cvt_pk_fp8_f32(a[i].z * sca, a[i].w * sca, w, true);
    wa[i] = (unsigned)w;
    w = __builtin_amdgcn_cvt_pk_fp8_f32(b[i].x * scb, b[i].y * scb, 0, false);
    w = __builtin_amdgcn_cvt_pk_fp8_f32(b[i].z * scb, b[i].w * scb, w, true);
    wb[i] = (unsigned)w;
  }
  *reinterpret_cast<uint4*>(d0 + (size_t)(lane >> 3) * (16384 * 128) + (lane & 7) * 16) = oa;
  *reinterpret_cast<uint4*>(d1 + (size_t)(lane >> 3) * (16384 * 128) + (lane & 7) * 16) = ob;
  if (lane == 0) { *i0 = exp2f(-ea); *i1 = exp2f(-eb); }
}
DI void convert_range(const float* src, u16* dst, size_t n8, size_t start, size_t stride) {
  for (size_t i = start; i < n8; i += stride) {
    float4 a = *reinterpret_cast<const float4*>(src + i * 8);
    float4 b = *reinterpret_cast<const float4*>(src + i * 8 + 4);
    uint4 o; o.x = pack2(a.x, a.y); o.y = pack2(a.z, a.w); o.z = pack2(b.x, b.y); o.w = pack2(b.z, b.w);
    *reinterpret_cast<uint4*>(dst + i * 8) = o;
  }
}

__device__ void phase0(const Params& p, int bid, int nb, char* smem) {
  float* tile = reinterpret_cast<float*>(smem);
  char* ws = p.ws;
  const int NTT = 1088 + 768 + 256 + 128 + 64 + 128 + 256 + 512;
  const bool late_in_fill = (nb * 70 >= 16384) && (nb * 14 >= 1856);
  for (int it = bid; it < NTT; it += nb) {
    if (late_in_fill && !(it < 1088 || (it >= 1856 && it < 2112))) continue;
    int i = it;
    const float* src; int N; u16* dst; int ld;
    if (i < 1088) { src = p.w_in; N = 4352; dst = (u16*)(ws + OFF_WINT); ld = 1024; }
    else if ((i -= 1088) < 768) { src = p.w_gate; N = 3072; dst = (u16*)(ws + OFF_WGT); ld = 1024; }
    else if ((i -= 768) < 256) { src = p.w_mem_kv; N = 1024; dst = (u16*)(ws + OFF_WKVT); ld = 1024; }
    else if ((i -= 256) < 128) { src = p.w_o_sb; N = 1024; dst = (u16*)(ws + OFF_WOT); ld = 1280; }
    else if ((i -= 128) < 64) { src = p.w_o_dil; N = 1024; dst = (u16*)(ws + OFF_WOT) + 512; ld = 1280; }
    else if ((i -= 64) < 128) { src = p.w_o_mem; N = 1024; dst = (u16*)(ws + OFF_WOT) + 768; ld = 1280; }
    else if ((i -= 128) < 256) { src = p.w_out; N = 1024; dst = (u16*)(ws + OFF_WOUTT); ld = 1024; }
    else { i -= 256; src = p.w_peer_q; N = 2048; dst = (u16*)(ws + OFF_WPQT); ld = 1024; }
    int ntn = N / 64;
    transpose_tile(src, N, dst, ld, i / ntn, i % ntn, tile);
  }
  const int w = __builtin_amdgcn_readfirstlane(threadIdx.x >> 6);
  u16* hbf = (u16*)((char*)p.out + OUT_OFF_H);
  u16* memh = (u16*)((char*)p.out + OUT_OFF_MEMH);
  {
    const int stride = nb * WPB;
    for (int row = bid * WPB + w; row < T_ + 2048; row += 2 * stride) {
      const int r1 = row + stride;
      const float* s0 = (row < T_) ? p.x + (size_t)row * 1024 : p.mem + (size_t)(row - T_) * 1024;
      const float* g0 = (row < T_) ? p.g_mix : p.g_mem;
      u16* d0 = (row < T_) ? hbf + (size_t)row * 1024 : memh + (size_t)(row - T_) * 1024;
      if (r1 < T_ + 2048) {
        const float* s1 = (r1 < T_) ? p.x + (size_t)r1 * 1024 : p.mem + (size_t)(r1 - T_) * 1024;
        const float* g1 = (r1 < T_) ? p.g_mix : p.g_mem;
        u16* d1 = (r1 < T_) ? hbf + (size_t)r1 * 1024 : memh + (size_t)(r1 - T_) * 1024;
        rmsnorm_row2(s0, g0, d0, s1, g1, d1);
      } else rmsnorm_row(s0, g0, d0);
    }
  }
  convert_range(p.subkeys, (u16*)(ws + OFF_SUBK), 262144 / 8, (size_t)bid * NTHR + threadIdx.x, (size_t)nb * NTHR);
  float* usc = (float*)(ws + OFF_USC);
  if (nb * 70 < 16384)
  for (int row = bid * WPB + w; row < 16384; row += nb * WPB)
    fp8_row2(p.peer_u + (size_t)row * 1024, (unsigned char*)(ws + OFF_U8) + (size_t)row * 128, usc + row * 2,
             p.peer_v + (size_t)row * 1024, (unsigned char*)(ws + OFF_V8) + (size_t)row * 128, usc + row * 2 + 1);
}

DI void p1_epilogue(const Params& p, char* ws, const float* Cs, int c0, int tok0, int kv, int tid) {
  if (!kv) {
    if (c0 < 512) epi_rowmajor<64, false>(Cs, (u16*)(ws + OFF_QSB), 8, c0 / 64, nullptr, 0.125f, 1, 2048, tok0, tid);
    else if (c0 < 1024) epi_rowmajor<64, false>(Cs, (u16*)(ws + OFF_KSB), 8, (c0 - 512) / 64, nullptr, 1.f, 1, 2048, tok0, tid);
    else if (c0 < 1536) epi_transposed<64, true>(Cs, (u16*)(ws + OFF_VTSB), 8, (c0 - 1024) / 64, 1, 2048, tok0, tid);
    else if (c0 < 2304) { int h0 = (c0 - 1536) / 64; epi_rowmajor<64, true>(Cs, (u16*)(ws + OFF_QD), 12, h0, p.g_q_dil, 0.125f, 1 << (2 * (h0 >> 2)), 2048, tok0, tid); }
    else if (c0 < 3072) { int h0 = (c0 - 2304) / 64; epi_rowmajor<64, true>(Cs, (u16*)(ws + OFF_KD), 12, h0, p.g_k_dil, 1.f, 1 << (2 * (h0 >> 2)), 2048, tok0, tid); }
    else if (c0 < 3840) { int h0 = (c0 - 3072) / 64; epi_transposed<64, true>(Cs, (u16*)(ws + OFF_VTD), 12, h0, 1 << (2 * (h0 >> 2)), 2048, tok0, tid); }
    else epi_rowmajor<128, true>(Cs, (u16*)(ws + OFF_QM), 4, (c0 - 3840) / 128, p.g_q_mem, 0.08838834764831845f, 1, 2048, tok0, tid);
  } else {
    if (c0 < 512) epi_rowmajor<128, true>(Cs, (u16*)(ws + OFF_KM), 4, c0 / 128, p.g_k_mem, 1.f, 1, 256, tok0, tid);
    else epi_transposed<128, false>(Cs, (u16*)(ws + OFF_VTM), 4, (c0 - 512) / 128, 1, 256, tok0, tid);
  }
}
__device__ void phase1(const Params& p, int bid, int nb, char* smem) {
  char* ws = p.ws;
  float* Cs = reinterpret_cast<float*>(smem);
  const u16* hbf = (const u16*)((char*)p.out + OUT_OFF_H);
  const u16* memh = (const u16*)((char*)p.out + OUT_OFF_MEMH);
  const int xcd = bid & 7, lb = bid >> 3, nlb = (nb + 7 - xcd) >> 3;
  for (int li = lb; li < 128; li += nlb) {
    const int tid = launder(threadIdx.x);
    f32x16 acc[4][2];
    zero_acc8(acc);
    const int tm = li >> 1, tn = 2 * xcd + (li & 1);
    gemm_mainloop8(acc, LdPlain{hbf + (size_t)tm * 256 * 1024, 1024}, LdPlain{(const u16*)(ws + OFF_WINT) + (size_t)tn * 256 * 1024, 1024}, 1024, smem, tid);
#pragma unroll 1
    for (int bj = 0; bj < 2; ++bj) {
      stage_half(acc, Cs, tid, bj);
      __syncthreads();
      p1_epilogue(p, ws, Cs, tn * 256 + bj * 128, tm * 256, 0, tid);
      __syncthreads();
    }
  }
  for (int hi = lb; hi < 24; hi += nlb) {
    const int tid = launder(threadIdx.x);
    f32x16 acc[2][2];
#pragma unroll
    for (int a = 0; a < 2; ++a)
#pragma unroll
      for (int b = 0; b < 2; ++b) acc[a][b] = zero16();
    int kv, tm, c0;
    if (hi < 16) { kv = 0; tm = 8 * xcd + (hi >> 1); c0 = 16 * 256 + (hi & 1) * 128; }
    else { kv = 1; tm = xcd; c0 = (hi - 16) * 128; }
    if (!kv) gemm_mainloop(acc, LdPlain{hbf + (size_t)tm * 256 * 1024, 1024}, LdPlain{(const u16*)(ws + OFF_WINT) + (size_t)c0 * 1024, 1024}, 1024, smem, tid);
    else gemm_mainloop(acc, LdPlain{memh + (size_t)tm * 256 * 1024, 1024}, LdPlain{(const u16*)(ws + OFF_WKVT) + (size_t)c0 * 1024, 1024}, 1024, smem, tid);
    stage_acc(acc, Cs, tid);
    __syncthreads();
    p1_epilogue(p, ws, Cs, c0, tm * 256, kv, tid);
    __syncthreads();
  }
}

DI void pack_p(const float* a, bf16x8& p0, bf16x8& p1) {
  uint4 u0 = pack8(a), u1 = pack8(a + 8);
  p0 = as_bf16x8(u0); p1 = as_bf16x8(u1);
}
DI void write_ot(const f32x16& o, float scale, u16* rowp, int db, int h) {
#pragma unroll
  for (int g = 0; g < 4; ++g) {
    uint2 v; v.x = pack2(o[4 * g] * scale, o[4 * g + 1] * scale); v.y = pack2(o[4 * g + 2] * scale, o[4 * g + 3] * scale);
    *reinterpret_cast<uint2*>(rowp + 32 * db + 8 * g + 4 * h) = v;
  }
}

#define KV_DECL uint4 sk0, sk1, sk2, sk3, sv0, sv1, sv2, sv3;
#define KV_FETCH(Kb, Vb, key0) { \
    const char* kp_ = reinterpret_cast<const char*>(Kb) + (uint32_t)((key0) * 128 + lane * 16); \
    const char* vp_ = reinterpret_cast<const char*>(Vb) + (uint32_t)(((key0) >> 5) * 4096 + lane * 16); \
    sk0 = *reinterpret_cast<const uint4*>(kp_); sk1 = *reinterpret_cast<const uint4*>(kp_ + 1024); \
    sk2 = *reinterpret_cast<const uint4*>(kp_ + 2048); sk3 = *reinterpret_cast<const uint4*>(kp_ + 3072); \
    sv0 = *reinterpret_cast<const uint4*>(vp_); sv1 = *reinterpret_cast<const uint4*>(vp_ + 1024); \
    sv2 = *reinterpret_cast<const uint4*>(vp_ + 2048); sv3 = *reinterpret_cast<const uint4*>(vp_ + 3072); }
#define KV_PARK(lk) { \
    char* lv_ = (lk) + 4096; const int kr_ = lane >> 3, kc_ = lane & 7, vd_ = lane >> 2, vq_ = lane & 3; \
    *reinterpret_cast<uint4*>((lk) + swz(kr_, kc_)) = sk0; *reinterpret_cast<uint4*>((lk) + swz(kr_ + 8, kc_)) = sk1; \
    *reinterpret_cast<uint4*>((lk) + swz(kr_ + 16, kc_)) = sk2; *reinterpret_cast<uint4*>((lk) + swz(kr_ + 24, kc_)) = sk3; \
    *reinterpret_cast<uint4*>(lv_ + vd_ * 64 + ((vq_ ^ ((vd_ >> 2) & 3)) << 4)) = sv0; \
    *reinterpret_cast<uint4*>(lv_ + (vd_ + 16) * 64 + ((vq_ ^ (((vd_ + 16) >> 2) & 3)) << 4)) = sv1; \
    *reinterpret_cast<uint4*>(lv_ + (vd_ + 32) * 64 + ((vq_ ^ (((vd_ + 32) >> 2) & 3)) << 4)) = sv2; \
    *reinterpret_cast<uint4*>(lv_ + (vd_ + 48) * 64 + ((vq_ ^ (((vd_ + 48) >> 2) & 3)) << 4)) = sv3; }
DI void kv_frags(bf16x8 (&kf)[4], bf16x8 (&vf)[2][2], const char* lk, int pin, int n, int h) {
  const char* lv = lk + 4096;
#pragma unroll
  for (int ks = 0; ks < 4; ++ks) kf[ks] = *reinterpret_cast<const bf16x8*>(lk + swz(pin, 4 * h + ks));
#pragma unroll
  for (int db = 0; db < 2; ++db)
#pragma unroll
    for (int s = 0; s < 2; ++s) {
      const int d = 32 * db + n;
      vf[db][s] = *reinterpret_cast<const bf16x8*>(lv + d * 64 + (((2 * s + h) ^ ((d >> 2) & 3)) << 4));
    }
}

__device__ void sb_task(const char* ws, char* outb, char* lk, int b, int hd, int qt) {
  const int lane = threadIdx.x & 63, n = lane & 31, h = lane >> 5;
  const u16* Qb = (const u16*)(ws + OFF_QSB) + (size_t)(b * 8 + hd) * 2048 * 64;
  const u16* Kb = (const u16*)(ws + OFF_KSB) + (size_t)(b * 8 + hd) * 2048 * 64;
  const u16* Vb = (const u16*)(ws + OFF_VTSB) + (size_t)(b * 8 + hd) * 64 * 2048;
  const int q0 = qt * 32;
  bf16x8 qf[4];
#pragma unroll
  for (int ks = 0; ks < 4; ++ks) qf[ks] = ld16(Qb + (uint32_t)((q0 + n) * 64 + 32 * h + 8 * ks));
  f32x16 o0 = zero16(), o1 = zero16();
  float carry = 0.f;
  const int pin = pi32(n);
  KV_DECL
  KV_FETCH(Kb, Vb, q0)
  for (int kb = qt; kb >= 0; --kb) {
    KV_PARK(lk)
    KV_FETCH(Kb, Vb, (kb > 0 ? kb - 1 : 0) * 32)
    bf16x8 kf[4], vf[2][2];
    kv_frags(kf, vf, lk, pin, n, h);
    f32x16 z = zero16();
#pragma unroll
    for (int ks = 0; ks < 4; ++ks) z = mfma32(kf[ks], qf[ks], z);
    const bool diag = (kb == qt);
    float sp[16], E[16];
#pragma unroll
    for (int r = 0; r < 16; ++r) {
      int kl = 16 * (r >> 3) + 8 * h + (r & 7);
      bool valid = (!diag) || (kl < n);
      float zz = z[r];
      float e = __expf(-fabsf(zz));
      float s = fmaxf(zz, 0.f) + __logf(1.f + e);
      sp[r] = valid ? s : 0.f;
    }
    E[7] = 0.f; E[15] = 0.f;
#pragma unroll
    for (int r = 6; r >= 0; --r) { E[r] = E[r + 1] + sp[r + 1]; E[r + 8] = E[r + 9] + sp[r + 9]; }
    float A0 = E[0] + sp[0], A1 = E[8] + sp[8];
    float B0 = __shfl_xor(A0, 32), B1 = __shfl_xor(A1, 32);
    float after0 = h ? (B1 + A1) : (B0 + A1 + B1);
    float after1 = h ? 0.f : B1;
    float a[16];
#pragma unroll
    for (int r = 0; r < 16; ++r) {
      int kl = 16 * (r >> 3) + 8 * h + (r & 7);
      bool valid = (!diag) || (kl < n);
      float bet = carry + ((r < 8) ? after0 : after1) + E[r];
      float v = __expf(z[r] - sp[r] - bet);
      a[r] = valid ? v : 0.f;
    }
    carry += A0 + A1 + B0 + B1;
    bf16x8 p0, p1;
    pack_p(a, p0, p1);
    o0 = mfma32(vf[0][0], p0, o0); o0 = mfma32(vf[0][1], p1, o0);
    o1 = mfma32(vf[1][0], p0, o1); o1 = mfma32(vf[1][1], p1, o1);
    if (__all(carry > 104.f)) break;
  }
  u16* rowp = (u16*)(outb + OUT_OFF_YSB) + (size_t)(b * 2048 + q0 + n) * 512 + hd * 64;
  write_ot(o0, 1.f, rowp, 0, h);
  write_ot(o1, 1.f, rowp, 1, h);
}

__device__ void dil_task(const char* ws, char* outb, char* lk, int b, int head, int pt) {
  const int lane = threadIdx.x & 63, n = lane & 31, h = lane >> 5;
  const int g = head >> 2, r_ = 1 << (2 * g), L = 2048 / r_;
  const int p0 = pt * 32, c = p0 / L, i0 = p0 % L;
  const float slope = exp2f(-8.f * (float)(head + 1) / 12.f) * (float)r_;
  const u16* Qb = (const u16*)(ws + OFF_QD) + (size_t)(b * 12 + head) * 2048 * 64;
  const u16* Kb = (const u16*)(ws + OFF_KD) + (size_t)(b * 12 + head) * 2048 * 64;
  const u16* Vb = (const u16*)(ws + OFF_VTD) + (size_t)(b * 12 + head) * 64 * 2048;
  bf16x8 qf[4];
#pragma unroll
  for (int ks = 0; ks < 4; ++ks) qf[ks] = ld16(Qb + (uint32_t)((p0 + n) * 64 + 32 * h + 8 * ks));
  f32x16 o0 = zero16(), o1 = zero16();
  float m = -1e30f, lsum = 0.f;
  const int pin = pi32(n);
  KV_DECL
  KV_FETCH(Kb, Vb, p0)
  for (int rel = 0; rel >= -4; --rel) {
    const int ib = i0 + 32 * rel;
    if (ib < 0) break;
    KV_PARK(lk)
    KV_FETCH(Kb, Vb, c * L + ((ib >= 32) ? ib - 32 : ib))
    bf16x8 kf[4], vf[2][2];
    kv_frags(kf, vf, lk, pin, n, h);
    f32x16 z = zero16();
#pragma unroll
    for (int ks = 0; ks < 4; ++ks) z = mfma32(kf[ks], qf[ks], z);
    float s[16];
    float bm = -1e30f;
#pragma unroll
    for (int r = 0; r < 16; ++r) {
      int kl = 16 * (r >> 3) + 8 * h + (r & 7);
      int gap = n - kl - 32 * rel;
      bool valid = (gap >= 0) && (gap <= 128);
      s[r] = valid ? (z[r] - slope * (float)gap) : -1e30f;
      bm = fmaxf(bm, s[r]);
    }
    bm = fmaxf(bm, __shfl_xor(bm, 32));
    float mn = fmaxf(m, bm);
    float alpha = __expf(m - mn);
    float a[16];
    float ps = 0.f;
#pragma unroll
    for (int r = 0; r < 16; ++r) { a[r] = __expf(s[r] - mn); ps += a[r]; }
    lsum = lsum * alpha + ps;
#pragma unroll
    for (int r = 0; r < 16; ++r) { o0[r] *= alpha; o1[r] *= alpha; }
    m = mn;
    bf16x8 p0, p1;
    pack_p(a, p0, p1);
    o0 = mfma32(vf[0][0], p0, o0); o0 = mfma32(vf[0][1], p1, o0);
    o1 = mfma32(vf[1][0], p0, o1); o1 = mfma32(vf[1][1], p1, o1);
  }
  float ltot = lsum + __shfl_xor(lsum, 32);
  float inv = 1.f / ltot;
  int t = c + r_ * (i0 + n);
  size_t token = (size_t)b * 2048 + t;
  u16* rowp = (u16*)(ws + OFF_YD) + (token * 12 + head) * 64;
  write_ot(o0, inv, rowp, 0, h);
  write_ot(o1, inv, rowp, 1, h);
  if (h == 0) ((float*)(outb + OUT_OFF_LSE))[token * 12 + head] = m + __logf(ltot);
}

__device__ void mem_block_task(const char* ws, char* smem, int b, int hm, int qgrp) {
  const int tid = threadIdx.x, lane = tid & 63, w = tid >> 6, n = lane & 31, h = lane >> 5;
  const u16* Qb = (const u16*)(ws + OFF_QM) + (size_t)(b * 4 + hm) * 2048 * 128;
  const char* Kg = ws + OFF_KM + (size_t)(b * 4 + hm) * 256 * 128 * 2;
  const char* Vg = ws + OFF_VTM + (size_t)(b * 4 + hm) * 128 * 256 * 2;
  char* lk = smem;
  char* lv = smem + 65536;
#pragma unroll
  for (int i = 0; i < 8; ++i) {
    const int idx = tid + 512 * i;
    const int kr = idx >> 4, kc = idx & 15;
    const uint4 kv = *reinterpret_cast<const uint4*>(Kg + (uint32_t)idx * 16u);
    const int vd = idx >> 5, vc = idx & 31;
    const uint4 vv = *reinterpret_cast<const uint4*>(Vg + (uint32_t)idx * 16u);
    *reinterpret_cast<uint4*>(lk + kr * 256 + ((kc ^ (kr & 15)) << 4)) = kv;
    *reinterpret_cast<uint4*>(lv + vd * 512 + ((vc ^ (vd & 15)) << 4)) = vv;
  }
  const int q0 = (qgrp * 8 + w) * 32;
  bf16x8 qf[8];
#pragma unroll
  for (int ks = 0; ks < 8; ++ks) qf[ks] = ld16(Qb + (uint32_t)((q0 + n) * 128 + 64 * h + 8 * ks));
  __syncthreads();
  f32x16 o[4];
#pragma unroll
  for (int db = 0; db < 4; ++db) o[db] = zero16();
  float m = -1e30f, lsum = 0.f;
  const int pin = pi32(n);
  for (int kb = 0; kb < 8; ++kb) {
    const int krow = kb * 32 + pin;
    const char* kp = lk + krow * 256;
    f32x16 z = zero16();
#pragma unroll
    for (int ks = 0; ks < 8; ++ks) z = mfma32(*reinterpret_cast<const bf16x8*>(kp + (((8 * h + ks) ^ (krow & 15)) << 4)), qf[ks], z);
    float bm = -1e30f;
#pragma unroll
    for (int r = 0; r < 16; ++r) bm = fmaxf(bm, z[r]);
    bm = fmaxf(bm, __shfl_xor(bm, 32));
    float mn = fmaxf(m, bm);
    float alpha = __expf(m - mn);
    float a[16];
    float ps = 0.f;
#pragma unroll
    for (int r = 0; r < 16; ++r) { a[r] = __expf(z[r] - mn); ps += a[r]; }
    lsum = lsum * alpha + ps;
    m = mn;
    bf16x8 p0, p1;
    pack_p(a, p0, p1);
#pragma unroll
    for (int db = 0; db < 4; ++db) {
      const int d = 32 * db + n;
      const char* vp = lv + d * 512;
      bf16x8 vf0 = *reinterpret_cast<const bf16x8*>(vp + (((4 * kb + h) ^ (d & 15)) << 4));
      bf16x8 vf1 = *reinterpret_cast<const bf16x8*>(vp + (((4 * kb + 2 + h) ^ (d & 15)) << 4));
#pragma unroll
      for (int r = 0; r < 16; ++r) o[db][r] *= alpha;
      o[db] = mfma32(vf0, p0, o[db]);
      o[db] = mfma32(vf1, p1, o[db]);
    }
  }
  float ltot = lsum + __shfl_xor(lsum, 32);
  float inv = 1.f / ltot;
  u16* rowp = (u16*)(ws + OFF_YM) + (size_t)(b * 2048 + q0 + n) * 512 + hm * 128;
#pragma unroll
  for (int db = 0; db < 4; ++db) write_ot(o[db], inv, rowp, db, h);
  __syncthreads();
}

__device__ void phase2(const Params& p, int bid, int nb, char* smem) {
  const char* ws = p.ws;
  const int w = __builtin_amdgcn_readfirstlane(threadIdx.x >> 6);
  const int gw = bid * WPB + w, nw = nb * WPB;
  char* lk = smem + w * 8192;
  for (int bt = bid; bt < 256; bt += nb) mem_block_task(ws, smem, bt >> 5, (bt >> 3) & 3, bt & 7);
  for (int task = gw; task < 4096 + 6144; task += nw) {
    if (task < 4096) {
      int qt = 63 - (task >> 6), bh = task & 63;
      sb_task(ws, (char*)p.out, lk, bh >> 3, bh & 7, qt);
    } else {
      int i = task - 4096;
      int pt = i & 63, bh = i >> 6;
      dil_task(ws, (char*)p.out, lk, bh / 12, bh % 12, pt);
    }
  }
}

__device__ void phase2b(const Params& p, int bid, int nb) {
  char* ws = p.ws;
  const size_t gt = (size_t)bid * NTHR + threadIdx.x, gs = (size_t)nb * NTHR;
  const u16* Yd = (const u16*)(ws + OFF_YD);
  const float* LSE = (const float*)((char*)p.out + OUT_OFF_LSE);
  u16* Ydm = (u16*)((char*)p.out + OUT_OFF_YDM);
  for (size_t i = gt; i < (size_t)T_ * 32; i += gs) {
    size_t t = i >> 5; int c = (int)(i & 31), hg = c >> 3, d0 = (c & 7) * 8;
    float l0 = LSE[t * 12 + hg], l1 = LSE[t * 12 + 4 + hg], l2 = LSE[t * 12 + 8 + hg];
    float mx = fmaxf(l0, fmaxf(l1, l2));
    float e0 = __expf(l0 - mx), e1 = __expf(l1 - mx), e2 = __expf(l2 - mx);
    float inv = 1.f / (e0 + e1 + e2);
    float wg[3] = {e0 * inv, e1 * inv, e2 * inv};
    float acc[8];
#pragma unroll
    for (int j = 0; j < 8; ++j) acc[j] = 0.f;
#pragma unroll
    for (int g = 0; g < 3; ++g) {
      uint4 v = *reinterpret_cast<const uint4*>(Yd + (t * 12 + g * 4 + hg) * 64 + d0);
      acc[0] += wg[g] * bf_lo(v.x); acc[1] += wg[g] * bf_hi(v.x); acc[2] += wg[g] * bf_lo(v.y); acc[3] += wg[g] * bf_hi(v.y);
      acc[4] += wg[g] * bf_lo(v.z); acc[5] += wg[g] * bf_hi(v.z); acc[6] += wg[g] * bf_lo(v.w); acc[7] += wg[g] * bf_hi(v.w);
    }
    *reinterpret_cast<uint4*>(Ydm + t * 256 + c * 8) = pack8(acc);
  }
}

__device__ void phase3(const Params& p, int bid, int nb, char* smem) {
  char* ws = p.ws;
  float* Cs = reinterpret_cast<float*>(smem);
  const u16* hbf = (const u16*)((char*)p.out + OUT_OFF_H);
  const int xcd = bid & 7, lb = bid >> 3, nlb = (nb + 7 - xcd) >> 3;
  for (int li = lb; li < 64; li += nlb) {
    const int tid = launder(threadIdx.x);
    const int lane = tid & 63, w = tid >> 6, wn = w & 1, n = lane & 31;
    const int tm = 8 * xcd + (li >> 3), tn = li & 7;
#pragma unroll 1
    for (int br = 0; br < 3; ++br) {
      f32x16 acc[2][2];
#pragma unroll
      for (int a = 0; a < 2; ++a)
#pragma unroll
        for (int b = 0; b < 2; ++b) acc[a][b] = zero16();
      gemm_mainloop(acc, LdPlain{hbf + (size_t)tm * 256 * 1024, 1024},
                    LdPlain{(const u16*)(ws + OFF_WGT) + (size_t)(br * 1024 + tn * 128) * 1024, 1024}, 1024, smem, tid);
      char* gscr = uniform_ptr(ws + OFF_GSCR + (size_t)bid * (NTHR * 8 * 16));
      const uint32_t toff = (uint32_t)tid * 16u;
#pragma unroll
      for (int mi = 0; mi < 2; ++mi)
#pragma unroll
        for (int ni = 0; ni < 2; ++ni) {
          float bias = p.b_gate[br * 1024 + tn * 128 + wn * 64 + ni * 32 + n];
#pragma unroll
          for (int q4 = 0; q4 < 2; ++q4) {
            uint32_t pk[4];
#pragma unroll
            for (int r = 0; r < 4; ++r) {
              float g0 = __builtin_amdgcn_rcpf(1.f + __expf(-(acc[mi][ni][8 * q4 + 2 * r] + bias)));
              float g1 = __builtin_amdgcn_rcpf(1.f + __expf(-(acc[mi][ni][8 * q4 + 2 * r + 1] + bias)));
              pk[r] = pack2(g0, g1);
            }
            *reinterpret_cast<uint4*>(gscr + ((mi * 2 + ni) * 2 + q4) * (NTHR * 16) + toff) = make_uint4(pk[0], pk[1], pk[2], pk[3]);
            __builtin_amdgcn_sched_barrier(0);
          }
        }
#pragma unroll
      for (int a = 0; a < 2; ++a)
#pragma unroll
        for (int b = 0; b < 2; ++b) acc[a][b] = zero16();
      const u16* Y; int ldy, Kb, koff;
      if (br == 0) { Y = (const u16*)((char*)p.out + OUT_OFF_YSB); ldy = 512; Kb = 512; koff = 0; }
      else if (br == 1) { Y = (const u16*)((char*)p.out + OUT_OFF_YDM); ldy = 256; Kb = 256; koff = 512; }
      else { Y = (const u16*)(ws + OFF_YM); ldy = 512; Kb = 512; koff = 768; }
      gemm_mainloop(acc, LdPlain{Y + (size_t)tm * 256 * ldy, ldy},
                    LdPlain{(const u16*)(ws + OFF_WOT) + (size_t)(tn * 128) * 1280 + koff, 1280}, Kb, smem, tid);
      char* tpark = uniform_ptr(ws + OFF_TPARK + (size_t)bid * (NTHR * 16 * 16));
#define P3_COMBINE(LOADP, STOREP) \
      _Pragma("unroll") for (int mi = 0; mi < 2; ++mi) \
      _Pragma("unroll") for (int ni = 0; ni < 2; ++ni) \
      _Pragma("unroll") for (int q4 = 0; q4 < 2; ++q4) { \
            uint4 gv = *reinterpret_cast<const uint4*>(gscr + ((mi * 2 + ni) * 2 + q4) * (NTHR * 16) + toff); \
            const uint32_t gw[4] = {gv.x, gv.y, gv.z, gv.w}; \
            _Pragma("unroll") for (int hf = 0; hf < 2; ++hf) { \
              float4 v; \
              v.x = bf_lo(gw[2 * hf]) * acc[mi][ni][8 * q4 + 4 * hf]; v.y = bf_hi(gw[2 * hf]) * acc[mi][ni][8 * q4 + 4 * hf + 1]; \
              v.z = bf_lo(gw[2 * hf + 1]) * acc[mi][ni][8 * q4 + 4 * hf + 2]; v.w = bf_hi(gw[2 * hf + 1]) * acc[mi][ni][8 * q4 + 4 * hf + 3]; \
              if (LOADP) { float4 t4 = *reinterpret_cast<const float4*>(tpark + (((mi * 2 + ni) * 2 + q4) * 2 + hf) * (NTHR * 16) + toff); v.x += t4.x; v.y += t4.y; v.z += t4.z; v.w += t4.w; } \
              if (STOREP) *reinterpret_cast<float4*>(tpark + (((mi * 2 + ni) * 2 + q4) * 2 + hf) * (NTHR * 16) + toff) = v; \
              acc[mi][ni][8 * q4 + 4 * hf] = v.x; acc[mi][ni][8 * q4 + 4 * hf + 1] = v.y; acc[mi][ni][8 * q4 + 4 * hf + 2] = v.z; acc[mi][ni][8 * q4 + 4 * hf + 3] = v.w; \
            } \
            __builtin_amdgcn_sched_barrier(0); \
      }
      if (br == 0) { P3_COMBINE(false, true) }
      else if (br == 1) { P3_COMBINE(true, true) }
      else { P3_COMBINE(true, false) }
      if (br == 2) stage_acc(acc, Cs, tid);
    }
    __syncthreads();
    {
      const int c8 = (tid & 15) * 8;
      u16* M = (u16*)(ws + OFF_MERGED);
#pragma unroll 2
      for (int pass = 0; pass < 8; ++pass) {
        int row = (tid >> 4) + 32 * pass;
        float v[8];
        float4 v0 = *reinterpret_cast<const float4*>(Cs + row * CLD + c8);
        float4 v1 = *reinterpret_cast<const float4*>(Cs + row * CLD + c8 + 4);
        v[0] = v0.x; v[1] = v0.y; v[2] = v0.z; v[3] = v0.w; v[4] = v1.x; v[5] = v1.y; v[6] = v1.z; v[7] = v1.w;
        *reinterpret_cast<uint4*>(M + (size_t)(tm * 256 + row) * 1024 + tn * 128 + c8) = pack8(v);
      }
    }
    __syncthreads();
  }
}

__device__ void phase4(const Params& p, int bid, int nb, char* smem) {
  char* ws = p.ws;
  float* Cs = reinterpret_cast<float*>(smem);
  const int xcd = bid & 7, lb = bid >> 3, nlb = (nb + 7 - xcd) >> 3;
  for (int li = lb; li < 32; li += nlb) {
    const int tid = launder(threadIdx.x);
    const int tm = 8 * xcd + (li >> 2), tn = li & 3;
    f32x16 acc[4][2];
    zero_acc8(acc);
    gemm_mainloop8(acc, LdPlain{(const u16*)(ws + OFF_MERGED) + (size_t)tm * 256 * 1024, 1024},
                  LdPlain{(const u16*)(ws + OFF_WOUTT) + (size_t)(tn * 256) * 1024, 1024}, 1024, smem, tid);
#pragma unroll 1
    for (int bj = 0; bj < 2; ++bj) {
      stage_half(acc, Cs, tid, bj);
      __syncthreads();
      const int c8 = (tid & 15) * 8, tn8 = tn * 2 + bj;
      u16* XG = (u16*)(ws + OFF_XG);
      float* rowss = (float*)(ws + OFF_ROWSS);
      const float4 g0 = *reinterpret_cast<const float4*>(p.g_ffn + tn8 * 128 + c8);
      const float4 g1 = *reinterpret_cast<const float4*>(p.g_ffn + tn8 * 128 + c8 + 4);
#pragma unroll 2
      for (int pass = 0; pass < 8; ++pass) {
        int row = (tid >> 4) + 32 * pass;
        size_t off = (size_t)(tm * 256 + row) * 1024 + tn8 * 128 + c8;
        float4 v0 = *reinterpret_cast<const float4*>(Cs + row * CLD + c8);
        float4 v1 = *reinterpret_cast<const float4*>(Cs + row * CLD + c8 + 4);
        float4 x0 = *reinterpret_cast<const float4*>(p.x + off);
        float4 x1 = *reinterpret_cast<const float4*>(p.x + off + 4);
        v0.x += x0.x; v0.y += x0.y; v0.z += x0.z; v0.w += x0.w;
        v1.x += x1.x; v1.y += x1.y; v1.z += x1.z; v1.w += x1.w;
        *reinterpret_cast<float4*>(p.out + off) = v0;
        *reinterpret_cast<float4*>(p.out + off + 4) = v1;
        float ss = v0.x * v0.x + v0.y * v0.y + v0.z * v0.z + v0.w * v0.w + v1.x * v1.x + v1.y * v1.y + v1.z * v1.z + v1.w * v1.w;
        ss += __shfl_xor(ss, 1); ss += __shfl_xor(ss, 2); ss += __shfl_xor(ss, 4); ss += __shfl_xor(ss, 8);
        if ((tid & 15) == 0) rowss[(size_t)(tm * 256 + row) * 8 + tn8] = ss;
        uint4 o; o.x = pack2(v0.x * g0.x, v0.y * g0.y); o.y = pack2(v0.z * g0.z, v0.w * g0.w);
        o.z = pack2(v1.x * g1.x, v1.y * g1.y); o.w = pack2(v1.z * g1.z, v1.w * g1.w);
        *reinterpret_cast<uint4*>(XG + off) = o;
      }
      __syncthreads();
    }
  }
}

#define DPP_MAX(v, ctrl) { uint32_t _t = (uint32_t)__builtin_amdgcn_update_dpp((int)(v), (int)(v), ctrl, 0xf, 0xf, false); v = (_t > v) ? _t : v; }
#define DPP_ADDF(v, ctrl) { float _t = __builtin_bit_cast(float, __builtin_amdgcn_update_dpp(__builtin_bit_cast(int, v), __builtin_bit_cast(int, v), ctrl, 0xf, 0xf, false)); v += _t; }

__device__ void phase6(const Params& p, int bid, int nb, char* smem) {
  char* ws = p.ws;
  float* Cs = reinterpret_cast<float*>(smem);
  const u16* h2 = (const u16*)(ws + OFF_XG);
  const float* rowss = (const float*)(ws + OFF_ROWSS);
  float* rstd_s = reinterpret_cast<float*>(smem + 98304);
  float* TS = (float*)(ws + OFF_TOPS);
  int* TI = (int*)(ws + OFF_TOPI);
  const int xcd = bid & 7, lb = bid >> 3, nlb = (nb + 7 - xcd) >> 3;
  for (int li = lb; li < 128; li += nlb) {
    const int tid = launder(threadIdx.x), lane = tid & 63, w = tid >> 6, wm = w >> 1, wn = w & 1, n = lane & 31, h = lane >> 5;
    int tm = 8 * xcd + (li >> 4), ct = li & 15;
    f32x16 acc[2][2];
#pragma unroll
    for (int a = 0; a < 2; ++a)
#pragma unroll
      for (int b = 0; b < 2; ++b) acc[a][b] = zero16();
    gemm_mainloop(acc, LdPlain{h2 + (size_t)tm * 256 * 1024, 1024},
                  LdPlain{(const u16*)(ws + OFF_WPQT) + (size_t)(ct * 128) * 1024, 1024}, 1024, smem, tid);
    if (tid < 256) {
      const float4 a = *reinterpret_cast<const float4*>(rowss + (size_t)(tm * 256 + tid) * 8);
      const float4 b = *reinterpret_cast<const float4*>(rowss + (size_t)(tm * 256 + tid) * 8 + 4);
      rstd_s[tid] = rsqrtf((a.x + a.y + a.z + a.w + b.x + b.y + b.z + b.w) * (1.f / 1024.f) + 1e-6f);
    }
    __syncthreads();
    {
      const u16* sk = (const u16*)(ws + OFF_SUBK) + (size_t)ct * 128 * 128;
      uint4 rb[4];
#pragma unroll
      for (int i = 0; i < 4; ++i) {
        int idx = tid + 512 * i, row = idx >> 4, c16 = idx & 15;
        rb[i] = *reinterpret_cast<const uint4*>(sk + row * 128 + c16 * 8);
      }
#pragma unroll
      for (int mi = 0; mi < 2; ++mi)
#pragma unroll
        for (int ni = 0; ni < 2; ++ni)
#pragma unroll
          for (int r = 0; r < 16; ++r) {
            int row = wm * 64 + mi * 32 + (r & 3) + 8 * (r >> 2) + 4 * h;
            int col = wn * 64 + ni * 32 + n;
            int panel = col >> 6, cc = col & 63;
            u16 bv = (u16)(pack2(acc[mi][ni][r] * rstd_s[row], 0.f) & 0xffffu);
            *reinterpret_cast<u16*>(smem + panel * 32768 + swz(row, cc >> 3) + (cc & 7) * 2) = bv;
          }
#pragma unroll
      for (int i = 0; i < 4; ++i) {
        int idx = tid + 512 * i, row = idx >> 4, c16 = idx & 15;
        *reinterpret_cast<uint4*>(smem + 65536 + (c16 >> 3) * 16384 + swz(row, c16 & 7)) = rb[i];
      }
    }
    __syncthreads();
#pragma unroll
    for (int a = 0; a < 2; ++a)
#pragma unroll
      for (int b = 0; b < 2; ++b) acc[a][b] = zero16();
#pragma unroll
    for (int pn = 0; pn < 2; ++pn)
#pragma unroll
      for (int ks = 0; ks < 4; ++ks) {
        bf16x8 af[2], bfr[2];
#pragma unroll
        for (int mi = 0; mi < 2; ++mi) af[mi] = *reinterpret_cast<const bf16x8*>(smem + pn * 32768 + swz(wm * 64 + mi * 32 + n, ks * 2 + h));
#pragma unroll
        for (int ni = 0; ni < 2; ++ni) bfr[ni] = *reinterpret_cast<const bf16x8*>(smem + 65536 + pn * 16384 + swz(wn * 64 + ni * 32 + n, ks * 2 + h));
#pragma unroll
        for (int mi = 0; mi < 2; ++mi)
#pragma unroll
          for (int ni = 0; ni < 2; ++ni) acc[mi][ni] = mfma32(af[mi], bfr[ni], acc[mi][ni]);
      }
    __syncthreads();
    stage_acc(acc, Cs, tid);
    __syncthreads();
    {
      const int q = lane >> 4, li = lane & 15;
#pragma unroll 1
      for (int grp = 0; grp < 8; grp += 2) {
        const int rowA = w * 32 + grp * 4 + q, rowB = rowA + 4;
        const float* rpA = Cs + rowA * CLD;
        const float* rpB = Cs + rowB * CLD;
        uint32_t kA[8], kB[8];
        {
          float4 v0 = *reinterpret_cast<const float4*>(rpA + li * 8), v1 = *reinterpret_cast<const float4*>(rpA + li * 8 + 4);
          float4 w0 = *reinterpret_cast<const float4*>(rpB + li * 8), w1 = *reinterpret_cast<const float4*>(rpB + li * 8 + 4);
          float va[8] = {v0.x, v0.y, v0.z, v0.w, v1.x, v1.y, v1.z, v1.w};
          float vb[8] = {w0.x, w0.y, w0.z, w0.w, w1.x, w1.y, w1.z, w1.w};
#pragma unroll
          for (int e = 0; e < 8; ++e) {
            uint32_t u = __float_as_uint(va[e]);
            u = (u & 0x80000000u) ? ~u : (u | 0x80000000u);
            kA[e] = (u & ~127u) | (uint32_t)(127 - (li * 8 + e));
            u = __float_as_uint(vb[e]);
            u = (u & 0x80000000u) ? ~u : (u | 0x80000000u);
            kB[e] = (u & ~127u) | (uint32_t)(127 - (li * 8 + e));
          }
        }
#pragma unroll
        for (int ph = 0; ph < 8; ++ph) {
#pragma unroll
          for (int e = (ph & 1); e + 1 < 8; e += 2) {
            uint32_t hi = kA[e] > kA[e + 1] ? kA[e] : kA[e + 1], lo = kA[e] > kA[e + 1] ? kA[e + 1] : kA[e];
            kA[e] = hi; kA[e + 1] = lo;
            hi = kB[e] > kB[e + 1] ? kB[e] : kB[e + 1]; lo = kB[e] > kB[e + 1] ? kB[e + 1] : kB[e];
            kB[e] = hi; kB[e + 1] = lo;
          }
        }
        uint32_t resA = 0, resB = 0;
#pragma unroll 4
        for (int itx = 0; itx < 16; ++itx) {
          uint32_t mA = kA[0], mB = kB[0];
          DPP_MAX(mA, 0xB1); DPP_MAX(mB, 0xB1);
          DPP_MAX(mA, 0x4E); DPP_MAX(mB, 0x4E);
          DPP_MAX(mA, 0x141); DPP_MAX(mB, 0x141);
          DPP_MAX(mA, 0x140); DPP_MAX(mB, 0x140);
          const bool wA = (kA[0] == mA), wB = (kB[0] == mB);
#pragma unroll
          for (int e = 0; e < 7; ++e) { kA[e] = wA ? kA[e + 1] : kA[e]; kB[e] = wB ? kB[e + 1] : kB[e]; }
          kA[7] = wA ? 0u : kA[7]; kB[7] = wB ? 0u : kB[7];
          resA = (li == itx) ? mA : resA; resB = (li == itx) ? mB : resB;
        }
        const int colA = 127 - (int)(resA & 127u), colB = 127 - (int)(resB & 127u);
        const float valA = rpA[colA], valB = rpB[colB];
        const size_t oA = ((size_t)(tm * 256 + rowA) * 16 + ct) * 16 + li, oB = ((size_t)(tm * 256 + rowB) * 16 + ct) * 16 + li;
        TS[oA] = valA; TI[oA] = colA; TS[oB] = valB; TI[oB] = colB;
      }
    }
    __syncthreads();
  }
}

DI f32x2 cvt8(unsigned w, bool hi) { return hi ? __builtin_amdgcn_cvt_pk_f32_fp8((int)w, true) : __builtin_amdgcn_cvt_pk_f32_fp8((int)w, false); }
constexpr size_t OFF_LIDX = OFF_QKV;
constexpr size_t OFF_GATE = OFF_QKV + 8 * MB;
constexpr size_t OFF_DOTS = OFF_QKV + 16 * MB;
#define DPP_F(v, ctrl) __builtin_bit_cast(float, __builtin_amdgcn_update_dpp(0, __builtin_bit_cast(int, (v)), ctrl, 0xf, 0xf, false))

__device__ void phase7a(const Params& p, int bid, int nb, char* smem) {
  char* ws = p.ws;
  const int lane = threadIdx.x & 63, w = __builtin_amdgcn_readfirstlane(threadIdx.x >> 6);
  int* lidx = reinterpret_cast<int*>(smem) + w * 896;
  float* lw = reinterpret_cast<float*>(smem) + w * 896 + 128;
  float* lts = reinterpret_cast<float*>(smem) + w * 896 + 384;
  int* lti = reinterpret_cast<int*>(smem) + w * 896 + 640;
  const float* TS = (const float*)(ws + OFF_TOPS);
  const int* TI = (const int*)(ws + OFF_TOPI);
  int* LIDX = (int*)(ws + OFF_LIDX);
  float* GATE = (float*)(ws + OFF_GATE);
  int ca, cb;
  if (lane < 16) { ca = 0; cb = lane; } else if (lane < 24) { ca = 1; cb = lane - 16; } else if (lane < 29) { ca = 2; cb = lane - 24; }
  else if (lane < 33) { ca = 3; cb = lane - 29; } else if (lane < 36) { ca = 4; cb = lane - 33; } else if (lane < 38) { ca = 5; cb = lane - 36; }
  else if (lane < 40) { ca = 6; cb = lane - 38; } else if (lane < 42) { ca = 7; cb = lane - 40; } else if (lane < 50) { ca = lane - 34; cb = 0; }
  else { ca = 0; cb = 0; }
  const bool isc = lane < 50;
  const int tstride = nb * WPB;
  int t = bid * WPB + w;
  float4 pts; int4 pti;
  if (t < T_) { pts = *reinterpret_cast<const float4*>(TS + (size_t)t * 256 + lane * 4); pti = *reinterpret_cast<const int4*>(TI + (size_t)t * 256 + lane * 4); }
  for (; t < T_; t += tstride) {
    *reinterpret_cast<float4*>(lts + lane * 4) = pts;
    *reinterpret_cast<int4*>(lti + lane * 4) = pti;
    if (t + tstride < T_) { pts = *reinterpret_cast<const float4*>(TS + (size_t)(t + tstride) * 256 + lane * 4); pti = *reinterpret_cast<const int4*>(TI + (size_t)(t + tstride) * 256 + lane * 4); }
    __builtin_amdgcn_fence(__ATOMIC_RELEASE, "wavefront");
    __builtin_amdgcn_wave_barrier();
#pragma unroll 2
    for (int hh = 0; hh < 8; ++hh) {
      const float key = lts[hh * 32 + ca] + lts[hh * 32 + 16 + cb];
      const int eidx = lti[hh * 32 + ca] * 128 + lti[hh * 32 + 16 + cb];
      uint32_t uk = __float_as_uint(key);
      uk = (uk & 0x80000000u) ? ~uk : (uk | 0x80000000u);
      uk = isc ? ((uk & ~63u) | (uint32_t)(63 - lane)) : 0u;
      int rank = 0;
#pragma unroll
      for (int j = 0; j < 50; ++j) {
        const uint32_t kj = (uint32_t)__builtin_amdgcn_readlane((int)uk, j);
        rank += (kj > uk) ? 1 : 0;
      }
      const bool sel = isc && rank < 16;
      const float mx = __builtin_bit_cast(float, __builtin_amdgcn_readlane(__builtin_bit_cast(int, key), 0));
      if (sel) { lidx[hh * 16 + rank] = eidx; lw[hh * 16 + rank] = __expf(key - mx); }
    }
    __builtin_amdgcn_fence(__ATOMIC_RELEASE, "wavefront");
    __builtin_amdgcn_wave_barrier();
    LIDX[(size_t)t * 128 + lane] = lidx[lane]; LIDX[(size_t)t * 128 + 64 + lane] = lidx[lane + 64];
    GATE[(size_t)t * 128 + lane] = lw[lane]; GATE[(size_t)t * 128 + 64 + lane] = lw[lane + 64];
    __builtin_amdgcn_fence(__ATOMIC_RELEASE, "wavefront");
    __builtin_amdgcn_wave_barrier();
  }
}

constexpr size_t OFF_PD = OFF_QKV + 16 * MB;
constexpr size_t OFF_WFIN = OFF_QKV + 80 * MB;
__device__ void phase7b(const Params& p, int bid, int nb, char* smem) {
  char* ws = p.ws;
  const int lane = threadIdx.x & 63, w = __builtin_amdgcn_readfirstlane(threadIdx.x >> 6);
  int* lidx0 = reinterpret_cast<int*>(smem) + w * 256;
  int* lidx1 = lidx0 + 128;
  const u16* XG = (const u16*)(ws + OFF_XG);
  const int* LIDX = (const int*)(ws + OFF_LIDX);
  const int xs = bid & 7;
  const unsigned char* U8 = (const unsigned char*)(ws + OFF_U8) + (size_t)xs * (16384 * 128);
  float* PD = (float*)(ws + OFF_PD) + (size_t)xs * T_ * 128;
  const int lwv = (bid >> 3) * WPB + w, nwv = ((nb + 7 - xs) >> 3) * WPB;
  const int j = lane >> 3, c = lane & 7;
  const bool c2 = (c & 4) != 0, c1 = (c & 2) != 0, c0 = (c & 1) != 0;
  const int itb = (c2 ? 8 : 0) + (c1 ? 4 : 0) + (c0 ? 2 : 0);
  const uint32_t coff = (uint32_t)(xs * 128 + c * 16);
  int pe0 = 0, pe1 = 0; uint4 pxa = make_uint4(0, 0, 0, 0), pxb = make_uint4(0, 0, 0, 0);
#define P7B_PREFETCH(tt) { pe0 = LIDX[(size_t)(tt) * 128 + lane]; pe1 = LIDX[(size_t)(tt) * 128 + 64 + lane]; \
    pxa = *reinterpret_cast<const uint4*>(XG + (size_t)(tt) * 1024 + coff); pxb = *reinterpret_cast<const uint4*>(XG + (size_t)(tt) * 1024 + coff + 8); }
#define P7B_STAGE(LB, BUF, HX, tt) { \
    LB[lane] = pe0; LB[lane + 64] = pe1; \
    HX[0] = f32x2{bf_lo(pxa.x), bf_hi(pxa.x)}; HX[1] = f32x2{bf_lo(pxa.y), bf_hi(pxa.y)}; HX[2] = f32x2{bf_lo(pxa.z), bf_hi(pxa.z)}; HX[3] = f32x2{bf_lo(pxa.w), bf_hi(pxa.w)}; \
    HX[4] = f32x2{bf_lo(pxb.x), bf_hi(pxb.x)}; HX[5] = f32x2{bf_lo(pxb.y), bf_hi(pxb.y)}; HX[6] = f32x2{bf_lo(pxb.z), bf_hi(pxb.z)}; HX[7] = f32x2{bf_lo(pxb.w), bf_hi(pxb.w)}; \
    if ((tt) + nwv < T_) P7B_PREFETCH((tt) + nwv) \
    __builtin_amdgcn_fence(__ATOMIC_RELEASE, "wavefront"); __builtin_amdgcn_wave_barrier(); \
    _Pragma("unroll") for (int it = 0; it < 16; ++it) { const int e_ = LB[it * 8 + j]; BUF[it] = *reinterpret_cast<const uint4*>(U8 + (uint32_t)(e_ * 128 + c * 16)); } }
#define P7B_COMP(BUF, HX, tt) { \
    float d_[16]; \
    _Pragma("unroll") for (int it = 0; it < 16; ++it) { \
      f32x2 d2 = cvt8(BUF[it].x, false) * HX[0]; \
      d2 += cvt8(BUF[it].x, true) * HX[1]; d2 += cvt8(BUF[it].y, false) * HX[2]; d2 += cvt8(BUF[it].y, true) * HX[3]; \
      d2 += cvt8(BUF[it].z, false) * HX[4]; d2 += cvt8(BUF[it].z, true) * HX[5]; d2 += cvt8(BUF[it].w, false) * HX[6]; d2 += cvt8(BUF[it].w, true) * HX[7]; \
      d_[it] = d2.x + d2.y; } \
    float e_[8]; \
    _Pragma("unroll") for (int i = 0; i < 8; ++i) { float mine = c2 ? d_[i + 8] : d_[i], snd = c2 ? d_[i] : d_[i + 8]; e_[i] = mine + DPP_F(snd, 0x141); } \
    float f_[4]; \
    _Pragma("unroll") for (int i = 0; i < 4; ++i) { float mine = c1 ? e_[i + 4] : e_[i], snd = c1 ? e_[i] : e_[i + 4]; f_[i] = mine + DPP_F(snd, 0x4E); } \
    float g_[2]; \
    _Pragma("unroll") for (int i = 0; i < 2; ++i) { float mine = c0 ? f_[i + 2] : f_[i], snd = c0 ? f_[i] : f_[i + 2]; g_[i] = mine + DPP_F(snd, 0xB1); } \
    PD[(size_t)(tt) * 128 + itb * 8 + j] = g_[0]; PD[(size_t)(tt) * 128 + (itb + 1) * 8 + j] = g_[1]; }
  int t = lwv;
  uint4 bA[16], bB[16];
  f32x2 hA[8], hB[8];
  if (t < T_) { P7B_PREFETCH(t) P7B_STAGE(lidx0, bA, hA, t) }
  for (; t < T_; t += 2 * nwv) {
    const int t1 = t + nwv, t2 = t + 2 * nwv;
    if (t1 < T_) P7B_STAGE(lidx1, bB, hB, t1)
    P7B_COMP(bA, hA, t)
    if (t1 < T_) {
      if (t2 < T_) P7B_STAGE(lidx0, bA, hA, t2)
      P7B_COMP(bB, hB, t1)
    }
  }
}

__device__ void phase7b2(const Params& p, int bid, int nb) {
  char* ws = p.ws;
  const int lane = threadIdx.x & 63, w = __builtin_amdgcn_readfirstlane(threadIdx.x >> 6);
  const float* USC = (const float*)(ws + OFF_USC);
  const float* rowss = (const float*)(ws + OFF_ROWSS);
  const int* LIDX = (const int*)(ws + OFF_LIDX);
  const float* GATE = (const float*)(ws + OFF_GATE);
  const float* PD = (const float*)(ws + OFF_PD);
  float* WF = (float*)(ws + OFF_WFIN);
  for (int t = bid * WPB + w; t < T_; t += nb * WPB) {
    const int e0 = LIDX[(size_t)t * 128 + lane], e1 = LIDX[(size_t)t * 128 + 64 + lane];
    const float g0 = GATE[(size_t)t * 128 + lane], g1 = GATE[(size_t)t * 128 + 64 + lane];
    float d0 = 0.f, d1 = 0.f;
#pragma unroll
    for (int x = 0; x < 8; ++x) { d0 += PD[((size_t)x * T_ + t) * 128 + lane]; d1 += PD[((size_t)x * T_ + t) * 128 + 64 + lane]; }
    const float pss = (lane < 8) ? rowss[(size_t)t * 8 + lane] : 0.f;
    const float rstd = rsqrtf(wave_sum(pss) * (1.f / 1024.f) + 1e-6f);
    const float2 sc0 = *reinterpret_cast<const float2*>(USC + (size_t)e0 * 2);
    const float2 sc1 = *reinterpret_cast<const float2*>(USC + (size_t)e1 * 2);
    const float da = d0 * rstd * sc0.x, db = d1 * rstd * sc1.x;
    const float acta = 0.5f * da * (1.f + erff(da * 0.70710678118654752f));
    const float actb = 0.5f * db * (1.f + erff(db * 0.70710678118654752f));
    float sa = g0, sb = g1;
    DPP_ADDF(sa, 0xB1); DPP_ADDF(sa, 0x4E); DPP_ADDF(sa, 0x141); DPP_ADDF(sa, 0x140);
    DPP_ADDF(sb, 0xB1); DPP_ADDF(sb, 0x4E); DPP_ADDF(sb, 0x141); DPP_ADDF(sb, 0x140);
    WF[(size_t)t * 128 + lane] = (g0 / sa) * acta * sc0.y;
    WF[(size_t)t * 128 + 64 + lane] = (g1 / sb) * actb * sc1.y;
  }
}

__device__ void phase7c(const Params& p, int bid, int nb, char* smem, float* dstbase) {
  char* ws = p.ws;
  const int lane = threadIdx.x & 63, w = __builtin_amdgcn_readfirstlane(threadIdx.x >> 6);
  int* lidx0 = reinterpret_cast<int*>(smem) + w * 1536;
  int* lidx1 = lidx0 + 128;
  float* lw0 = reinterpret_cast<float*>(smem) + w * 1536 + 256;
  float* lw1 = lw0 + 128;
  float* red = reinterpret_cast<float*>(smem) + w * 1536 + 512;
  const int* LIDX = (const int*)(ws + OFF_LIDX);
  const float* WF = (const float*)(ws + OFF_WFIN);
  const int xs = bid & 7;
  const unsigned char* V8 = (const unsigned char*)(ws + OFF_V8) + (size_t)xs * (16384 * 128);
  const int lwv = (bid >> 3) * WPB + w, nwv = ((nb + 7 - xs) >> 3) * WPB;
  const int j = lane >> 3, c = lane & 7;
  const uint32_t coff = (uint32_t)(xs * 128 + c * 16);
  int pe0 = 0, pe1 = 0; float pw0 = 0.f, pw1 = 0.f;
#define P7C_PREFETCH(tt) { pe0 = LIDX[(size_t)(tt) * 128 + lane]; pe1 = LIDX[(size_t)(tt) * 128 + 64 + lane]; \
    pw0 = WF[(size_t)(tt) * 128 + lane]; pw1 = WF[(size_t)(tt) * 128 + 64 + lane]; }
#define P7C_STAGE(LB, LWB, BUF, tt) { \
    LB[lane] = pe0; LB[lane + 64] = pe1; LWB[lane] = pw0; LWB[lane + 64] = pw1; \
    if ((tt) + nwv < T_) P7C_PREFETCH((tt) + nwv) \
    __builtin_amdgcn_fence(__ATOMIC_RELEASE, "wavefront"); __builtin_amdgcn_wave_barrier(); \
    _Pragma("unroll") for (int it = 0; it < 16; ++it) { const int e_ = LB[it * 8 + j]; BUF[it] = *reinterpret_cast<const uint4*>(V8 + (uint32_t)(e_ * 128 + c * 16)); } }
#define P7C_COMP(LWB, BUF, tt) { \
    f32x2 acc[8]; \
    _Pragma("unroll") for (int q = 0; q < 8; ++q) acc[q] = f32x2{0.f, 0.f}; \
    _Pragma("unroll") for (int it = 0; it < 16; ++it) { \
      const float wk_ = LWB[it * 8 + j]; const f32x2 w2 = f32x2{wk_, wk_}; \
      acc[0] += w2 * cvt8(BUF[it].x, false); acc[1] += w2 * cvt8(BUF[it].x, true); \
      acc[2] += w2 * cvt8(BUF[it].y, false); acc[3] += w2 * cvt8(BUF[it].y, true); \
      acc[4] += w2 * cvt8(BUF[it].z, false); acc[5] += w2 * cvt8(BUF[it].z, true); \
      acc[6] += w2 * cvt8(BUF[it].w, false); acc[7] += w2 * cvt8(BUF[it].w, true); } \
    _Pragma("unroll") for (int q = 0; q < 4; ++q) \
      *reinterpret_cast<float4*>(red + j * 128 + c * 16 + q * 4) = make_float4(acc[2 * q].x, acc[2 * q].y, acc[2 * q + 1].x, acc[2 * q + 1].y); \
    __builtin_amdgcn_fence(__ATOMIC_RELEASE, "wavefront"); __builtin_amdgcn_wave_barrier(); \
    float2 sum = *reinterpret_cast<const float2*>(red + 2 * lane); \
    _Pragma("unroll") for (int jj = 1; jj < 8; ++jj) { float2 v = *reinterpret_cast<const float2*>(red + jj * 128 + 2 * lane); sum.x += v.x; sum.y += v.y; } \
    const size_t o = (size_t)(tt) * 1024 + xs * 128 + 2 * lane; \
    float2 x0 = *reinterpret_cast<const float2*>(p.out + o); \
    x0.x += sum.x; x0.y += sum.y; \
    *reinterpret_cast<float2*>(dstbase + o) = x0; \
    __builtin_amdgcn_fence(__ATOMIC_RELEASE, "wavefront"); __builtin_amdgcn_wave_barrier(); }
  int t = lwv;
  uint4 bA[16], bB[16];
  if (t < T_) { P7C_PREFETCH(t) P7C_STAGE(lidx0, lw0, bA, t) }
  for (; t < T_; t += 2 * nwv) {
    const int t1 = t + nwv, t2 = t + 2 * nwv;
    if (t1 < T_) P7C_STAGE(lidx1, lw1, bB, t1)
    P7C_COMP(lw0, bA, t)
    if (t1 < T_) {
      if (t2 < T_) P7C_STAGE(lidx0, lw0, bA, t2)
      P7C_COMP(lw1, bB, t1)
    }
  }
}

#define XB_TMO      128
#define XB_XCNT(j)  (256  + 64 * (j))
#define XB_XSUB(j)  (1280 + 64 * (j))
#define XB_XGEN(j)  (2304 + 64 * (j))
#define XB_TOP      3328
#define XB_TOPGEN   3392
#define XCD_BAR_WORDS 3456
#define XB_SPIN_CAP (1u << 20)
#define LAS __attribute__((address_space(3)))
DI unsigned xb_ld(unsigned* p)              { return __hip_atomic_load(p, __ATOMIC_RELAXED, __HIP_MEMORY_SCOPE_AGENT); }
DI unsigned xb_add(unsigned* p, unsigned v) { return __hip_atomic_fetch_add(p, v, __ATOMIC_RELAXED, __HIP_MEMORY_SCOPE_AGENT); }
DI unsigned xb_xcc_id() { return (unsigned)__builtin_amdgcn_s_getreg((3 << 11) | 20) & 0xFu; }
#define XB_SPIN(cond, bar) do { unsigned _sp = 0; while (cond) { __builtin_amdgcn_s_sleep(1); \
    if ((++_sp & 255u) == 0u) { if (xb_ld(&(bar)[XB_TMO])) break; if (_sp > XB_SPIN_CAP) { atomicAdd(&(bar)[XB_TMO], 1u); break; } } } } while (0)
struct XcdBarrier { unsigned* bar; unsigned x; volatile LAS unsigned* st; };
DI XcdBarrier xcd_barrier_post(unsigned* bar, volatile LAS unsigned* st) {
  XcdBarrier b; b.bar = bar; b.x = xb_xcc_id(); b.st = st;
  if (threadIdx.x == 0) (void)xb_add(&bar[XB_XCNT(b.x)], 1u);
  return b;
}
DI void xcd_barrier_complete(unsigned* bar, unsigned x, unsigned& nloc, unsigned& nx) {
  const unsigned G = gridDim.x * gridDim.y * gridDim.z;
  unsigned sum, cnt, mine, sp = 0u;
  for (;;) {
    sum = 0u; cnt = 0u; mine = 0u;
#pragma unroll
    for (unsigned j = 0; j < 16; ++j) { const unsigned c = xb_ld(&bar[XB_XCNT(j)]); sum += c; cnt += (c > 0u) ? 1u : 0u; mine = (j == x) ? c : mine; }
    if (sum == G) break;
    __builtin_amdgcn_s_sleep(1);
    if ((++sp & 255u) == 0u) { if (xb_ld(&bar[XB_TMO])) break; if (sp > XB_SPIN_CAP) { atomicAdd(&bar[XB_TMO], 1u); break; } }
  }
  nloc = mine > 0u ? mine : 1u; nx = cnt > 0u ? cnt : 1u;
}
DI void wave_transpose_tile(const float* src, int N, u16* dst, int dst_ld, int tk, int tn, float* tile) {
  const int lane = threadIdx.x & 63;
  const int r0 = lane >> 4, c4 = (lane & 15) * 4;
  const float* sp = src + (size_t)(tk * 64 + r0) * N + tn * 64 + c4;
#pragma unroll
  for (int i = 0; i < 16; ++i) {
    const float4 v = *reinterpret_cast<const float4*>(sp + (size_t)(4 * i) * N);
    float* t0 = tile + (r0 + 4 * i) * 65 + c4;
    t0[0] = v.x; t0[1] = v.y; t0[2] = v.z; t0[3] = v.w;
  }
  __builtin_amdgcn_fence(__ATOMIC_RELEASE, "wavefront");
  __builtin_amdgcn_wave_barrier();
  const int n0 = lane >> 3, kc = (lane & 7) * 8;
#pragma unroll
  for (int i = 0; i < 8; ++i) {
    const float* tp = tile + kc * 65 + n0 + 8 * i;
    uint4 o;
    o.x = pack2(tp[0], tp[65]); o.y = pack2(tp[2 * 65], tp[3 * 65]); o.z = pack2(tp[4 * 65], tp[5 * 65]); o.w = pack2(tp[6 * 65], tp[7 * 65]);
    *reinterpret_cast<uint4*>(dst + (size_t)(tn * 64 + n0 + 8 * i) * dst_ld + tk * 64 + kc) = o;
  }
  __builtin_amdgcn_fence(__ATOMIC_RELEASE, "wavefront");
  __builtin_amdgcn_wave_barrier();
}
#define WT_RANGE(T, START, COUNT, SRC, NN, DST, LD) if ((T) >= (START) && (T) < (START) + (COUNT)) { const int i_ = (T) - (START); \
    wave_transpose_tile(SRC, NN, DST, LD, i_ / ((NN) / 64), i_ % ((NN) / 64), wtile); }
DI void xcd_barrier(const XcdBarrier& b, const Params* fp = nullptr, int fill = -1, int bid = 0, int nb = 1, char* fsmem = nullptr) {
  asm volatile("s_waitcnt vmcnt(0)" ::: "memory");
  __syncthreads();
  if (fill >= 0 && threadIdx.x >= 64) {
    const int wv = __builtin_amdgcn_readfirstlane(threadIdx.x >> 6);
    const int slot = fill * 7 + (wv - 1);
    float* usc = (float*)(fp->ws + OFF_USC);
    if (fill < 2 && nb * 14 >= 1856) {
      float* wtile = reinterpret_cast<float*>(fsmem) + wv * (64 * 65 + 16);
      char* ws_ = fp->ws;
      const int t = slot * nb + bid;
      WT_RANGE(t, 0, 768, fp->w_gate, 3072, (u16*)(ws_ + OFF_WGT), 1024)
      WT_RANGE(t, 768, 128, fp->w_o_sb, 1024, (u16*)(ws_ + OFF_WOT), 1280)
      WT_RANGE(t, 896, 64, fp->w_o_dil, 1024, (u16*)(ws_ + OFF_WOT) + 512, 1280)
      WT_RANGE(t, 960, 128, fp->w_o_mem, 1024, (u16*)(ws_ + OFF_WOT) + 768, 1280)
      WT_RANGE(t, 1088, 256, fp->w_out, 1024, (u16*)(ws_ + OFF_WOUTT), 1024)
      WT_RANGE(t, 1344, 512, fp->w_peer_q, 2048, (u16*)(ws_ + OFF_WPQT), 1024)
    }
#pragma unroll 1
    for (int j = 0; j < 2; ++j) {
      const int r = (slot * nb + bid) * 2 + j;
      if (r < 16384)
        fp8_row2(fp->peer_u + (size_t)r * 1024, (unsigned char*)(fp->ws + OFF_U8) + (size_t)r * 128, usc + r * 2,
                 fp->peer_v + (size_t)r * 1024, (unsigned char*)(fp->ws + OFF_V8) + (size_t)r * 128, usc + r * 2 + 1);
    }
  }
  if (threadIdx.x == 0) {
    unsigned* bar = b.bar;
    __builtin_amdgcn_s_waitcnt(0);
    unsigned nloc = b.st[0], nx = b.st[1];
    if (nloc == 0u) { xcd_barrier_complete(bar, b.x, nloc, nx); b.st[0] = nloc; b.st[1] = nx; }
    const unsigned old = xb_add(&bar[XB_XSUB(b.x)], 1u);
    const unsigned gen = old / nloc;
    if (old + 1u == (gen + 1u) * nloc) {
      __builtin_amdgcn_fence(__ATOMIC_RELEASE, "agent");
      asm volatile("s_waitcnt vmcnt(0)" ::: "memory");
      const unsigned og = xb_add(&bar[XB_TOP], 1u);
      const unsigned tg = og / nx;
      if (og + 1u == (tg + 1u) * nx) xb_add(&bar[XB_TOPGEN], 1u);
      else XB_SPIN(xb_ld(&bar[XB_TOPGEN]) == tg, bar);
      __builtin_amdgcn_fence(__ATOMIC_ACQUIRE, "agent");
      xb_add(&bar[XB_XGEN(b.x)], 1u);
      asm volatile("s_waitcnt vmcnt(0)" ::: "memory");
    } else {
      XB_SPIN(xb_ld(&bar[XB_XGEN(b.x)]) == gen, bar);
      __builtin_amdgcn_fence(__ATOMIC_ACQUIRE, "agent");
      asm volatile("s_waitcnt vmcnt(0)" ::: "memory");
    }
  }
  __syncthreads();
}

constexpr int SMEM_BYTES = 3 * STAGE_BYTES;

#if MK_FUSED
__global__ void __launch_bounds__(NTHR, 2) mega_kernel(Params p) {
  __shared__ __attribute__((aligned(16))) char smem[SMEM_BYTES];
  cg::grid_group grid = cg::this_grid();
  __shared__ uint4 xb_words;
  if (threadIdx.x == 0) xb_words = make_uint4(0u, 0u, 0u, 0u);
  __syncthreads();
  (void)xcd_barrier_post((unsigned*)(p.ws + OFF_BAR), (volatile LAS unsigned*)&xb_words);
  const int bid = blockIdx.x, nb = gridDim.x;
#define XBAR() { XcdBarrier xb_; xb_.bar = (unsigned*)(p.ws + OFF_BAR); xb_.x = xb_xcc_id(); xb_.st = (volatile LAS unsigned*)&xb_words; xcd_barrier(xb_); }
#define RUNP(ph, call) { int nrep_ = launder_s((PROBE_DUP & (1 << ph)) ? 2 : 1); _Pragma("unroll 1") for (int rep_ = 0; rep_ < nrep_; ++rep_) { call; XBAR() } }
#define XBARF(bi) { XcdBarrier xb_; xb_.bar = (unsigned*)(p.ws + OFF_BAR); xb_.x = xb_xcc_id(); xb_.st = (volatile LAS unsigned*)&xb_words; \
                    xcd_barrier(xb_, &p, (nb * 70 >= 16384) ? (bi) : -1, bid, nb, smem); }
  phase0(p, bid, nb, smem); XBARF(0)
  phase1(p, bid, nb, smem); XBARF(1)
  phase2(p, bid, nb, smem); XBARF(2)
  phase2b(p, bid, nb); XBARF(3)
  phase3(p, bid, nb, smem); XBARF(4)
  RUNP(5, phase4(p, bid, nb, smem))
  RUNP(7, phase6(p, bid, nb, smem))
  phase7a(p, bid, nb, smem); XBAR()
  phase7b(p, bid, nb, smem); XBAR()
  phase7b2(p, bid, nb); XBAR()
  phase7c(p, bid, nb, smem, p.out);
  if (p.ws == nullptr) grid.sync();
}
#else
#define PHASE_KERNEL(name, call) \
  __global__ void __launch_bounds__(NTHR, 2) name(Params p) { \
    __shared__ __attribute__((aligned(16))) char smem[SMEM_BYTES]; \
    const int bid = blockIdx.x, nb = gridDim.x; (void)smem; call; }
PHASE_KERNEL(k_p0, phase0(p, bid, nb, smem))
PHASE_KERNEL(k_p1, phase1(p, bid, nb, smem))
PHASE_KERNEL(k_p2, phase2(p, bid, nb, smem))
PHASE_KERNEL(k_p2b, phase2b(p, bid, nb))
PHASE_KERNEL(k_p3, phase3(p, bid, nb, smem))
PHASE_KERNEL(k_p4, phase4(p, bid, nb, smem))
PHASE_KERNEL(k_p6, phase6(p, bid, nb, smem))
PHASE_KERNEL(k_p7a, phase7a(p, bid, nb, smem))
PHASE_KERNEL(k_p7b, phase7b(p, bid, nb, smem))
PHASE_KERNEL(k_p7b2, phase7b2(p, bid, nb))
PHASE_KERNEL(k_p7c, phase7c(p, bid, nb, smem, p.out))
#endif

extern "C" void kernel_launch(void* const* d_in, const int* in_sizes, int n_in, void* d_out, int out_size, void* d_ws,
                              size_t ws_size, hipStream_t stream) {
  Params p{};
  p.x = (const float*)d_in[0]; p.mem = (const float*)d_in[1]; p.g_mix = (const float*)d_in[2]; p.g_mem = (const float*)d_in[3];
  p.w_in = (const float*)d_in[4]; p.w_mem_kv = (const float*)d_in[5]; p.g_q_dil = (const float*)d_in[6]; p.g_k_dil = (const float*)d_in[7];
  p.g_q_mem = (const float*)d_in[8]; p.g_k_mem = (const float*)d_in[9]; p.w_o_sb = (const float*)d_in[10]; p.w_o_dil = (const float*)d_in[11];
  p.w_o_mem = (const float*)d_in[12]; p.w_gate = (const float*)d_in[13]; p.b_gate = (const float*)d_in[14]; p.w_out = (const float*)d_in[15];
  p.g_ffn = (const float*)d_in[16]; p.w_peer_q = (const float*)d_in[17]; p.subkeys = (const float*)d_in[18]; p.peer_u = (const float*)d_in[19];
  p.peer_v = (const float*)d_in[20];
  p.out = (float*)d_out; p.ws = (char*)d_ws;
#if MK_FUSED
  static int grid_blocks = 0;
  if (!grid_blocks) {
    int dev = 0, cus = 0, per_cu = 0;
    hipGetDevice(&dev);
    hipDeviceGetAttribute(&cus, hipDeviceAttributeMultiprocessorCount, dev);
    hipOccupancyMaxActiveBlocksPerMultiprocessor(&per_cu, mega_kernel, NTHR, 0);
    per_cu = 1;
    grid_blocks = (cus * per_cu) & ~7;
  }
  hipMemsetAsync((char*)d_ws + OFF_BAR, 0, XCD_BAR_WORDS * sizeof(unsigned), stream);
  void* args[] = {&p};
  hipError_t e = hipLaunchCooperativeKernel((void*)mega_kernel, dim3(grid_blocks), dim3(NTHR), args, 0, stream);
  if (e != hipSuccess) fprintf(stderr, "cooperative launch failed: %s (grid %d)\n", hipGetErrorString(e), grid_blocks);
#else
  const int G = 512;
  k_p0<<<G, NTHR, 0, stream>>>(p);
  k_p1<<<G, NTHR, 0, stream>>>(p);
  k_p2<<<G, NTHR, 0, stream>>>(p);
  k_p2b<<<G, NTHR, 0, stream>>>(p);
  k_p3<<<G, NTHR, 0, stream>>>(p);
  k_p4<<<G, NTHR, 0, stream>>>(p);
  k_p6<<<G, NTHR, 0, stream>>>(p);
  k_p7a<<<G, NTHR, 0, stream>>>(p);
  k_p7b<<<G, NTHR, 0, stream>>>(p);
  k_p7b2<<<G, NTHR, 0, stream>>>(p);
  k_p7c<<<G, NTHR, 0, stream>>>(p);
#endif
}
```
